# Optimizing an MI355X kernel written in HIP

```python
import math
import jax, jax.numpy as jnp
from jax import lax
import numpy as np

D_MODEL = 1024
BATCH = 8
SEQ = 4096
DEPTH = 2

HEAD_DIM = 64
MOBA_HEADS = D_MODEL // (2 * HEAD_DIM)
MOBA_BLOCK = 256
MOBA_TOPK = 3
NSA_HEADS = D_MODEL // (2 * HEAD_DIM)
NSA_KV_GROUPS = 2
NSA_HEADS_PER_GROUP = NSA_HEADS // NSA_KV_GROUPS
NSA_CMP_BLOCK = 32
NSA_CMP_STRIDE = 16
NSA_CMP_HIDDEN = 256
NSA_SLC_BLOCK = 64
NSA_TOPN = 16
NSA_WINDOW = 512
NSA_FORCE_SCORE = 1e6
FOX_HEADS = D_MODEL // HEAD_DIM
D_FF = 4 * D_MODEL
REL_BUCKETS = 32
REL_MAX_DISTANCE = 1024
QUERY_BLOCK = 128
SEQ_ALIGN = MOBA_BLOCK
RMS_EPS = 1e-5
NEG_INF = -1e30

MOBA_W = MOBA_HEADS * HEAD_DIM
NSA_W = NSA_HEADS * HEAD_DIM
NSA_KV_W = NSA_KV_GROUPS * HEAD_DIM
EVEN_SPLITS = (MOBA_W, MOBA_W, MOBA_W, NSA_W) + (NSA_KV_W,) * 6 + (3 * NSA_HEADS,)
EVEN_IN = sum(EVEN_SPLITS)
FOX_W = FOX_HEADS * HEAD_DIM
ODD_SPLITS = (FOX_W, FOX_W, FOX_W, FOX_HEADS)
ODD_IN = sum(ODD_SPLITS)
N_BIAS_HEADS = MOBA_HEADS + NSA_HEADS

kernel_name = 'moba_nsa_fox_hybrid_trunk'


def _split(t, sizes):
    offs = [int(o) for o in np.cumsum(sizes)[:-1]]
    return jnp.split(t, offs, axis=-1)


def rmsnorm(x, g):
    xf = x.astype(jnp.float32)
    y = xf * lax.rsqrt(jnp.mean(xf * xf, axis=-1, keepdims=True) + RMS_EPS)
    return (y * g.astype(jnp.float32)).astype(x.dtype)


def masked_softmax(logits, mask):
    logits = jnp.where(mask, logits.astype(jnp.float32), NEG_INF)
    p = jax.nn.softmax(logits, axis=-1)
    return p * jnp.any(mask, axis=-1, keepdims=True)


def rel_bucket(dist):
    n = jnp.maximum(dist, 0)
    max_exact = REL_BUCKETS // 2
    nf = jnp.maximum(n, 1).astype(jnp.float32)
    large = max_exact + (jnp.log(nf / max_exact) / math.log(REL_MAX_DISTANCE / max_exact)
                         * (REL_BUCKETS - max_exact)).astype(jnp.int32)
    large = jnp.minimum(large, REL_BUCKETS - 1)
    return jnp.where(n < max_exact, n, large)


def moba_nsa_mixer(h, w_in, w_out, rel_bias, cmp_pos_k, cmp_pos_v,
                   cmp_k_w1, cmp_k_w2, cmp_v_w1, cmp_v_w2):
    B, S, _ = h.shape
    S_pad = -(-S // SEQ_ALIGN) * SEQ_ALIGN
    hp = jnp.pad(h, ((0, 0), (0, S_pad - S), (0, 0)))
    mq, mk, mv, nq, kc, vc, ksl, vsl, kwn, vwn, gz = _split(hp @ w_in, EVEN_SPLITS)
    scale = HEAD_DIM ** -0.5
    Q = QUERY_BLOCK
    G, J = NSA_KV_GROUPS, NSA_HEADS_PER_GROUP
    n_qc = S_pad // Q
    f32 = jnp.float32

    n_mb = S_pad // MOBA_BLOCK
    k_moba = min(MOBA_TOPK, n_mb)
    mq = mq.reshape(B, S_pad, MOBA_HEADS, HEAD_DIM).transpose(0, 2, 1, 3)
    mk = mk.reshape(B, n_mb, MOBA_BLOCK, MOBA_HEADS, HEAD_DIM).transpose(0, 3, 1, 2, 4)
    mv = mv.reshape(B, n_mb, MOBA_BLOCK, MOBA_HEADS, HEAD_DIM).transpose(0, 3, 1, 2, 4)
    k_mean = jnp.mean(mk, axis=3)

    nq = nq.reshape(B, S_pad, NSA_HEADS, HEAD_DIM).transpose(0, 2, 1, 3)
    n_cmp = (S_pad - NSA_CMP_BLOCK) // NSA_CMP_STRIDE + 1
    cmp_idx = np.arange(n_cmp)[:, None] * NSA_CMP_STRIDE + np.arange(NSA_CMP_BLOCK)[None, :]
    cmp_end = jnp.asarray(cmp_idx[:, -1])

    def compress(raw, pos, w1, w2):
        blocks = raw.reshape(B, S_pad, G, HEAD_DIM)[:, cmp_idx] + pos[:, None, :]
        blocks = blocks.transpose(0, 3, 1, 2, 4).reshape(B, G, n_cmp, NSA_CMP_BLOCK * HEAD_DIM)
        return jax.nn.silu(blocks @ w1) @ w2

    k_cmp = compress(kc, cmp_pos_k, cmp_k_w1, cmp_k_w2)
    v_cmp = compress(vc, cmp_pos_v, cmp_v_w1, cmp_v_w2)
    n_sb = S_pad // NSA_SLC_BLOCK
    n_sel = min(NSA_TOPN, n_sb)
    k_slc = ksl.reshape(B, n_sb, NSA_SLC_BLOCK, G, HEAD_DIM).transpose(0, 3, 1, 2, 4)
    v_slc = vsl.reshape(B, n_sb, NSA_SLC_BLOCK, G, HEAD_DIM).transpose(0, 3, 1, 2, 4)
    pad_w = ((0, 0), (0, 0), (NSA_WINDOW, 0), (0, 0))
    k_win = jnp.pad(kwn.reshape(B, S_pad, G, HEAD_DIM).transpose(0, 2, 1, 3), pad_w)
    v_win = jnp.pad(vwn.reshape(B, S_pad, G, HEAD_DIM).transpose(0, 2, 1, 3), pad_w)
    gates = jax.nn.sigmoid(gz.reshape(B, S_pad, NSA_HEADS, 3).transpose(0, 2, 1, 3))
    ci = np.arange(n_cmp)[:, None] * NSA_CMP_STRIDE
    sj = np.arange(n_sb)[None, :] * NSA_SLC_BLOCK
    overlap = jnp.asarray(((ci < sj + NSA_SLC_BLOCK) & (ci + NSA_CMP_BLOCK > sj)).astype(np.float32))

    table = rel_bias.T
    tb_moba = table[:MOBA_HEADS]
    tb_nsa = table[MOBA_HEADS:].reshape(G, J, REL_BUCKETS)
    h_m = jnp.arange(MOBA_HEADS)[:, None, None]
    g_i = jnp.arange(G)[:, None, None]
    g5 = jnp.arange(G)[:, None, None, None, None]
    j5 = jnp.arange(J)[None, :, None, None, None]

    def query_block(bc):
        b, c = bc
        q0 = c * Q
        t = q0 + jnp.arange(Q)
        qm = lax.dynamic_slice_in_dim(mq[b], q0, Q, axis=1)
        mk_b, mv_b = mk[b], mv[b]
        blk = q0 // MOBA_BLOCK
        route = jnp.einsum('hqd,hnd->hqn', qm, k_mean[b]).astype(f32)
        route = jnp.where(jnp.arange(n_mb) < blk, route, NEG_INF)
        _, sel = lax.top_k(route, k_moba)
        sel_ok = sel < blk
        k_sel = mk_b[h_m, sel]
        v_sel = mv_b[h_m, sel]
        k_own = lax.dynamic_index_in_dim(mk_b, blk, axis=1, keepdims=False)
        v_own = lax.dynamic_index_in_dim(mv_b, blk, axis=1, keepdims=False)
        d_sel = t[:, None, None] - (sel[..., None] * MOBA_BLOCK + jnp.arange(MOBA_BLOCK))
        d_own = t[:, None] - (blk * MOBA_BLOCK + jnp.arange(MOBA_BLOCK))[None, :]
        s_sel = (jnp.einsum('hqd,hqnkd->hqnk', qm, k_sel).astype(f32) * scale
                 + tb_moba[h_m[..., None], rel_bucket(d_sel)])
        s_own = (jnp.einsum('hqd,hkd->hqk', qm, k_own).astype(f32) * scale
                 + tb_moba[:, rel_bucket(d_own)])
        n_k = k_moba * MOBA_BLOCK
        m_sel = jnp.broadcast_to(sel_ok[..., None], d_sel.shape).reshape(MOBA_HEADS, Q, n_k)
        m_own = jnp.broadcast_to((d_own >= 0)[None], s_own.shape)
        p = masked_softmax(jnp.concatenate([s_sel.reshape(MOBA_HEADS, Q, n_k), s_own], axis=-1),
                           jnp.concatenate([m_sel, m_own], axis=-1))
        o_a = (jnp.einsum('hqnk,hqnkd->hqd', p[..., :n_k].reshape(MOBA_HEADS, Q, k_moba, MOBA_BLOCK), v_sel)
               + jnp.einsum('hqk,hkd->hqd', p[..., n_k:], v_own))
        qn = lax.dynamic_slice_in_dim(nq[b], q0, Q, axis=1).reshape(G, J, Q, HEAD_DIM)
        d_cmp = t[:, None] - cmp_end[None, :]
        s_cmp = (jnp.einsum('gjqd,gnd->gjqn', qn, k_cmp[b]).astype(f32) * scale
                 + tb_nsa[:, :, rel_bucket(d_cmp)])
        p_cmp = masked_softmax(s_cmp, (d_cmp >= 0)[None, None])
        o_cmp = jnp.einsum('gjqn,gnd->gjqd', p_cmp, v_cmp[b])
        imp = jnp.einsum('gjqn,nm->gqm', p_cmp, overlap)
        s_blk = t // NSA_SLC_BLOCK
        jb = jnp.arange(n_sb)[None, :]
        forced = (jb == 0) | (jb == s_blk[:, None]) | (jb == s_blk[:, None] - 1)
        imp = jnp.where(forced, imp + NSA_FORCE_SCORE, jnp.where(jb <= s_blk[:, None], imp, NEG_INF))
        _, sidx = lax.top_k(imp, n_sel)
        k_s = k_slc[b][g_i, sidx]
        v_s = v_slc[b][g_i, sidx]
        d_s = t[:, None, None] - (sidx[..., None] * NSA_SLC_BLOCK + jnp.arange(NSA_SLC_BLOCK))
        m_s = (d_s >= 0) & (sidx <= s_blk[:, None])[..., None]
        s_s = (jnp.einsum('gjqd,gqnkd->gjqnk', qn, k_s).astype(f32) * scale
               + tb_nsa[g5, j5, rel_bucket(d_s)[:, None]])
        n_ks = n_sel * NSA_SLC_BLOCK
        p_s = masked_softmax(s_s.reshape(G, J, Q, n_ks), m_s.reshape(G, 1, Q, n_ks))
        o_slc = jnp.einsum('gjqnk,gqnkd->gjqd', p_s.reshape(G, J, Q, n_sel, NSA_SLC_BLOCK), v_s)
        k_w = lax.dynamic_slice_in_dim(k_win[b], q0, Q + NSA_WINDOW, axis=1)
        v_w = lax.dynamic_slice_in_dim(v_win[b], q0, Q + NSA_WINDOW, axis=1)
        pos_w = q0 - NSA_WINDOW + jnp.arange(Q + NSA_WINDOW)
        d_w = t[:, None] - pos_w[None, :]
        m_w = (d_w >= 0) & (d_w < NSA_WINDOW) & (pos_w >= 0)[None, :]
        s_w = (jnp.einsum('gjqd,gkd->gjqk', qn, k_w).astype(f32) * scale
               + tb_nsa[:, :, rel_bucket(d_w)])
        p_w = masked_softmax(s_w, m_w[None, None])
        o_win = jnp.einsum('gjqk,gkd->gjqd', p_w, v_w)
        g = lax.dynamic_slice_in_dim(gates[b], q0, Q, axis=1).astype(f32)
        o_b = (g[..., 0:1] * o_cmp.reshape(NSA_HEADS, Q, HEAD_DIM)
               + g[..., 1:2] * o_slc.reshape(NSA_HEADS, Q, HEAD_DIM)
               + g[..., 2:3] * o_win.reshape(NSA_HEADS, Q, HEAD_DIM))
        return jnp.concatenate([o_a.astype(f32), o_b.astype(f32)], axis=0)

    b_idx = jnp.repeat(jnp.arange(B), n_qc)
    c_idx = jnp.tile(jnp.arange(n_qc), B)
    o = lax.map(query_block, (b_idx, c_idx))
    o = o.reshape(B, n_qc, MOBA_HEADS + NSA_HEADS, Q, HEAD_DIM).transpose(0, 1, 3, 2, 4)
    o = o.reshape(B, S_pad, MOBA_W + NSA_W)[:, :S]
    return o.astype(h.dtype) @ w_out


def fox_mixer(h, w_in, b_forget, w_out):
    B, S, _ = h.shape
    Q = QUERY_BLOCK
    scale = HEAD_DIM ** -0.5
    q, k, v, fz = _split(h @ w_in, ODD_SPLITS)
    q = q.reshape(B, S, FOX_HEADS, HEAD_DIM).transpose(0, 2, 1, 3)
    k = k.reshape(B, S, FOX_HEADS, HEAD_DIM).transpose(0, 2, 1, 3)
    v = v.reshape(B, S, FOX_HEADS, HEAD_DIM).transpose(0, 2, 1, 3)
    log_f = jax.nn.log_sigmoid((fz + b_forget).astype(jnp.float32))
    cum = jnp.cumsum(log_f, axis=1).transpose(0, 2, 1)
    key_pos = jnp.arange(S)

    def block(c):
        q0 = c * Q
        qc = lax.dynamic_slice_in_dim(q, q0, Q, axis=2)
        cq = lax.dynamic_slice_in_dim(cum, q0, Q, axis=2)
        t = q0 + jnp.arange(Q)
        s = (jnp.einsum('bhqd,bhkd->bhqk', qc, k).astype(jnp.float32) * scale
             + cq[..., None] - cum[:, :, None, :])
        p = masked_softmax(s, key_pos[None, :] <= t[:, None])
        return jnp.einsum('bhqk,bhkd->bhqd', p, v).astype(jnp.float32)

    o = lax.map(block, jnp.arange(S // Q))
    o = o.transpose(1, 0, 3, 2, 4).reshape(B, S, FOX_W)
    return o.astype(h.dtype) @ w_out


def sqrelu_mlp(h, w1, w2):
    a = jax.nn.relu(h @ w1)
    return (a * a) @ w2


def setup_inputs(seed: int = 0) -> dict:
    key = jax.random.key(seed)
    ks = jax.random.split(key, 20)
    f32 = jnp.float32

    def nrm(k, shape, scale):
        return jax.random.normal(k, shape, f32) * scale

    n_even = (DEPTH + 1) // 2
    n_odd = DEPTH // 2
    cmp_in = NSA_CMP_BLOCK * HEAD_DIM
    return {
        'x': nrm(ks[0], (BATCH, SEQ, D_MODEL), 1.0),
        'rel_bias': nrm(ks[1], (REL_BUCKETS, N_BIAS_HEADS), 0.5),
        'mix_norm': 1.0 + nrm(ks[2], (DEPTH, D_MODEL), 0.02),
        'mlp_norm': 1.0 + nrm(ks[3], (DEPTH, D_MODEL), 0.02),
        'even_w_in': nrm(ks[4], (n_even, D_MODEL, EVEN_IN), D_MODEL ** -0.5),
        'even_w_out': nrm(ks[5], (n_even, MOBA_W + NSA_W, D_MODEL), (MOBA_W + NSA_W) ** -0.5),
        'cmp_pos_k': nrm(ks[6], (n_even, NSA_CMP_BLOCK, HEAD_DIM), 0.2),
        'cmp_pos_v': nrm(ks[7], (n_even, NSA_CMP_BLOCK, HEAD_DIM), 0.2),
        'cmp_k_w1': nrm(ks[8], (n_even, cmp_in, NSA_CMP_HIDDEN), cmp_in ** -0.5),
        'cmp_k_w2': nrm(ks[9], (n_even, NSA_CMP_HIDDEN, HEAD_DIM), NSA_CMP_HIDDEN ** -0.5),
        'cmp_v_w1': nrm(ks[10], (n_even, cmp_in, NSA_CMP_HIDDEN), cmp_in ** -0.5),
        'cmp_v_w2': nrm(ks[11], (n_even, NSA_CMP_HIDDEN, HEAD_DIM), NSA_CMP_HIDDEN ** -0.5),
        'odd_w_in': nrm(ks[12], (n_odd, D_MODEL, ODD_IN), D_MODEL ** -0.5),
        'odd_b_forget': 3.0 + nrm(ks[13], (n_odd, FOX_HEADS), 0.5),
        'odd_w_out': nrm(ks[14], (n_odd, FOX_W, D_MODEL), FOX_W ** -0.5),
        'mlp_w1': nrm(ks[15], (DEPTH, D_MODEL, D_FF), D_MODEL ** -0.5),
        'mlp_w2': nrm(ks[16], (DEPTH, D_FF, D_MODEL), D_FF ** -0.5),
        'final_norm': 1.0 + nrm(ks[17], (D_MODEL,), 0.02),
    }


def reference(x, rel_bias, mix_norm, mlp_norm, even_w_in, even_w_out, cmp_pos_k, cmp_pos_v,
              cmp_k_w1, cmp_k_w2, cmp_v_w1, cmp_v_w2, odd_w_in, odd_b_forget, odd_w_out,
              mlp_w1, mlp_w2, final_norm):
    h = x
    for layer in range(DEPTH):
        hn = rmsnorm(h, mix_norm[layer])
        i = layer // 2
        if layer % 2 == 0:
            h = h + moba_nsa_mixer(hn, even_w_in[i], even_w_out[i], rel_bias,
                                   cmp_pos_k[i], cmp_pos_v[i], cmp_k_w1[i], cmp_k_w2[i],
                                   cmp_v_w1[i], cmp_v_w2[i])
        else:
            h = h + fox_mixer(hn, odd_w_in[i], odd_b_forget[i], odd_w_out[i])
        h = h + sqrelu_mlp(rmsnorm(h, mlp_norm[layer]), mlp_w1[layer], mlp_w2[layer])
    return rmsnorm(h, final_norm)
```

```cpp
#include <hip/hip_runtime.h>
#include <cstdio>
#include <cstdint>
namespace pg8 {
#define PG8_LAS __attribute__((address_space(3)))
typedef unsigned short bf16_t;
typedef short bf16x8 __attribute__((ext_vector_type(8)));
typedef float f32x4 __attribute__((ext_vector_type(4)));
typedef unsigned u32x4 __attribute__((ext_vector_type(4)));
typedef unsigned u32x2 __attribute__((ext_vector_type(2)));
constexpr int BM = 256, BK = 64, HALF = 128, HTB = HALF * BK * 2  , STAGE_BYTES = 8 * HTB, NXCD = 8, WGM = 8;

__host__ __device__ __forceinline__ int lds_byte(int r, int c) { const int st = (r >> 4) * 2 + (c >> 5), rr = r & 15, cc = c & 31, ob = rr * 64 + cc * 2; return st * 1024 + (ob ^ (((ob >> 9) & 1) << 5)); }
__host__ __device__ __forceinline__ void stage_rc(int b, int& R, int& C) { const int st = b / 1024, sb = b % 1024, swz = sb ^ (((sb >> 9) & 1) << 5); R = (st >> 1) * 16 + swz / 64; C = (st & 1) * 32 + (swz % 64) / 2; }
__host__ __device__ __forceinline__ int perm32(int rho) { const int n = rho >> 4, i = rho & 15; return 8 * (i >> 2) + 4 * n + (i & 3); }

struct Unit { int pm, pn; };
struct Gemm { const bf16_t* A; const bf16_t* Bt; int M, N, K, lda; };

struct StaticOrder {
    int nM, nN, nwg, G, c;
    __host__ __device__ void init(int M, int N, int G_, int c_) { nM = M / BM; nN = N / BM; nwg = nM * nN; G = G_; c = c_; }
    __host__ __device__ bool next(int i, Unit& u) const {
        const long L = (long)i * G + c; if (L >= nwg) return false;
        int wgid = (int)L; { const int q = nwg / NXCD, r = nwg % NXCD, xcd = wgid % NXCD, off = wgid / NXCD; wgid = (xcd < r ? xcd * (q + 1) : r * (q + 1) + (xcd - r) * q) + off; }
        const int nig = WGM * nN, gid = wgid / nig, fm = gid * WGM, gsz = (nM - fm) < WGM ? (nM - fm) : WGM;
        u.pm = fm + ((wgid % nig) % gsz); u.pn = (wgid % nig) / gsz; return true;
    }
};
struct CmpOrder {
    int G, c;
    __device__ bool next(int i, Unit& u) const { const int L = i * G + c; if (L >= 32) return false; u.pm = L; u.pn = L >> 4; return true; }
};

__device__ __forceinline__ unsigned cvt_pk_bf16(float lo, float hi) { unsigned r; asm volatile("v_cvt_pk_bf16_f32 %0, %1, %2" : "=v"(r) : "v"(lo), "v"(hi)); return r; }

struct EpiProj {
    static constexpr bool PERM = true;
    bf16_t* O; int ldc; const float* ssq; float c2; unsigned qtiles; int cmp_tile; bf16_t* cmpin; int gate_tile; float* gz; float* km;
    __device__ __forceinline__ void operator()(const f32x4 (&acc)[2][2][4][2], const Unit& u, int wr, int wc, int fr, int fq, PG8_LAS const float* rs_tab) const {
        const int row0 = u.pm * BM + wr * 64 + fr; const int colt = u.pn * BM;
        const float sc = ((qtiles >> u.pn) & 1u) ? c2 : 1.f;
        const bool iscmp = (u.pn == cmp_tile);
        if (u.pn == gate_tile) {
            if (wc == 0) {
#pragma unroll
                for (int ai = 0; ai < 2; ++ai)
#pragma unroll
                    for (int m = 0; m < 4; ++m) { const int row = row0 + ai * HALF + m * 16; const float rs = rs_tab[row & 255];
                        *(f32x4*)(gz + (size_t)row * 32 + 8 * fq) = acc[ai][0][m][0] * rs; *(f32x4*)(gz + (size_t)row * 32 + 8 * fq + 4) = acc[ai][0][m][1] * rs; } }
            return;
        }
        const bool iskm = (km != nullptr) && (u.pn == 2 || u.pn == 3);
        float cs[2][2][4];
#pragma unroll
        for (int bj = 0; bj < 2; ++bj)
#pragma unroll
            for (int n = 0; n < 2; ++n)
#pragma unroll
                for (int e = 0; e < 4; ++e) cs[bj][n][e] = 0.f;
#pragma unroll
        for (int ai = 0; ai < 2; ++ai)
#pragma unroll
            for (int m = 0; m < 4; ++m) { const int row = row0 + ai * HALF + m * 16; const float rs = sc * rs_tab[row & 255];
#pragma unroll
                for (int bj = 0; bj < 2; ++bj) { const f32x4 v0 = acc[ai][bj][m][0] * rs, v1 = acc[ai][bj][m][1] * rs;
                    u32x4 w; w.x = cvt_pk_bf16(v0[0], v0[1]); w.y = cvt_pk_bf16(v0[2], v0[3]); w.z = cvt_pk_bf16(v1[0], v1[1]); w.w = cvt_pk_bf16(v1[2], v1[3]);
                    if (iskm) {
#pragma unroll
                        for (int e = 0; e < 4; ++e) { cs[bj][0][e] += v0[e]; cs[bj][1][e] += v1[e]; } }
                    bf16_t* dst;
                    if (iscmp) { const int b = row >> 12, s = row & 4095, g = wc >> 1, d0 = 32 * (wc & 1) + 8 * fq; dst = cmpin + ((size_t)((bj * 16 + b * 2 + g) * 4096 + s)) * 64 + d0; }
                    else dst = O + (size_t)row * ldc + colt + bj * HALF + wc * 32 + 8 * fq;
                    *(u32x4*)dst = w; } }
        if (iskm) {
            const int b = u.pm >> 4, nb = u.pm & 15;
#pragma unroll
            for (int bj = 0; bj < 2; ++bj)
#pragma unroll
                for (int n = 0; n < 2; ++n)
#pragma unroll
                    for (int e = 0; e < 4; ++e) { float s = cs[bj][n][e]; s += __shfl_xor(s, 1); s += __shfl_xor(s, 2); s += __shfl_xor(s, 4); s += __shfl_xor(s, 8);
                        if (fr == 0) { const int c = bj * HALF + wc * 32 + 8 * fq + 4 * n + e; const int h = (u.pn - 2) * 4 + (c >> 6), d = c & 63;
                            atomicAdd(km + ((b * 8 + h) * 16 + nb) * 64 + d, s * (1.0f / 256.0f)); } }
        }
    }
};
struct EpiUp {
    static constexpr bool PERM = true;
    bf16_t* O; int ldc; const float* ssq;
    __device__ __forceinline__ void operator()(const f32x4 (&acc)[2][2][4][2], const Unit& u, int wr, int wc, int fr, int fq, PG8_LAS const float* rs_tab) const {
        const int row0 = u.pm * BM + wr * 64 + fr; const int col0 = u.pn * BM + wc * 32 + 8 * fq;
#pragma unroll
        for (int ai = 0; ai < 2; ++ai)
#pragma unroll
            for (int m = 0; m < 4; ++m) { const int row = row0 + ai * HALF + m * 16; const float rs = rs_tab[row & 255];
#pragma unroll
                for (int bj = 0; bj < 2; ++bj) { f32x4 v0 = acc[ai][bj][m][0] * rs, v1 = acc[ai][bj][m][1] * rs;
#pragma unroll
                    for (int e = 0; e < 4; ++e) { const float a = fmaxf(v0[e], 0.f), b = fmaxf(v1[e], 0.f); v0[e] = a * a; v1[e] = b * b; }
                    u32x4 w; w.x = cvt_pk_bf16(v0[0], v0[1]); w.y = cvt_pk_bf16(v0[2], v0[3]); w.z = cvt_pk_bf16(v1[0], v1[1]); w.w = cvt_pk_bf16(v1[2], v1[3]);
                    *(u32x4*)(O + (size_t)row * ldc + col0 + bj * HALF) = w; } }
    }
};
struct EpiSilu {
    static constexpr bool PERM = true;
    bf16_t* O; const float* posb;
    __device__ __forceinline__ void operator()(const f32x4 (&acc)[2][2][4][2], const Unit& u, int wr, int wc, int fr, int fq, PG8_LAS const float* rs_tab) const {
        const int row0 = u.pm * BM + wr * 64 + fr; const int col0 = wc * 32 + 8 * fq;
#pragma unroll
        for (int bj = 0; bj < 2; ++bj) { const f32x4 b0 = *(const f32x4*)(posb + u.pn * 256 + col0 + bj * HALF), b1 = *(const f32x4*)(posb + u.pn * 256 + col0 + bj * HALF + 4);
#pragma unroll
            for (int ai = 0; ai < 2; ++ai)
#pragma unroll
                for (int m = 0; m < 4; ++m) { const int row = row0 + ai * HALF + m * 16; f32x4 v0 = acc[ai][bj][m][0] + b0, v1 = acc[ai][bj][m][1] + b1;
#pragma unroll
                    for (int e = 0; e < 4; ++e) { v0[e] = v0[e] / (1.f + __expf(-v0[e])); v1[e] = v1[e] / (1.f + __expf(-v1[e])); }
                    u32x4 w; w.x = cvt_pk_bf16(v0[0], v0[1]); w.y = cvt_pk_bf16(v0[2], v0[3]); w.z = cvt_pk_bf16(v1[0], v1[1]); w.w = cvt_pk_bf16(v1[2], v1[3]);
                    *(u32x4*)(O + (size_t)row * 256 + col0 + bj * HALF) = w; } }
    }
};
template <int MODE> struct EpiResT {
    static constexpr bool PERM = true;
    const float* base; float* out; bf16_t* xb; bf16_t* xl; float* ssq;
    __device__ __forceinline__ static void unpack8(const u32x4 a, const u32x4 b, f32x4& h0, f32x4& h1) {
        h0[0] = __builtin_bit_cast(float, a.x << 16) + __builtin_bit_cast(float, b.x << 16); h0[1] = __builtin_bit_cast(float, a.x & 0xffff0000u) + __builtin_bit_cast(float, b.x & 0xffff0000u);
        h0[2] = __builtin_bit_cast(float, a.y << 16) + __builtin_bit_cast(float, b.y << 16); h0[3] = __builtin_bit_cast(float, a.y & 0xffff0000u) + __builtin_bit_cast(float, b.y & 0xffff0000u);
        h1[0] = __builtin_bit_cast(float, a.z << 16) + __builtin_bit_cast(float, b.z << 16); h1[1] = __builtin_bit_cast(float, a.z & 0xffff0000u) + __builtin_bit_cast(float, b.z & 0xffff0000u);
        h1[2] = __builtin_bit_cast(float, a.w << 16) + __builtin_bit_cast(float, b.w << 16); h1[3] = __builtin_bit_cast(float, a.w & 0xffff0000u) + __builtin_bit_cast(float, b.w & 0xffff0000u);
    }
    __device__ __forceinline__ void operator()(const f32x4 (&acc)[2][2][4][2], const Unit& u, int wr, int wc, int fr, int fq, PG8_LAS const float* rs_tab) const {
        const int row0 = u.pm * BM + wr * 64 + fr, col0 = u.pn * BM + wc * 32 + 8 * fq;
#pragma unroll
        for (int ai = 0; ai < 2; ++ai) {
            u32x4 pre[4][2][2];
#pragma unroll
            for (int m = 0; m < 4; ++m) { const size_t off = (size_t)(row0 + ai * HALF + m * 16) * 1024 + col0;
#pragma unroll
                for (int bj = 0; bj < 2; ++bj) {
                    if (MODE == 0) { pre[m][bj][0] = *(const u32x4*)(base + off + bj * HALF); pre[m][bj][1] = *(const u32x4*)(base + off + bj * HALF + 4); }
                    else { pre[m][bj][0] = *(const u32x4*)(xb + off + bj * HALF); pre[m][bj][1] = *(const u32x4*)(xl + off + bj * HALF); } } }
            asm volatile("" ::: "memory");
#pragma unroll
            for (int m = 0; m < 4; ++m) { const int row = row0 + ai * HALF + m * 16; const size_t off = (size_t)row * 1024 + col0; float q = 0.f;
#pragma unroll
                for (int bj = 0; bj < 2; ++bj) { f32x4 h0, h1;
                    if (MODE == 0) { h0 = __builtin_bit_cast(f32x4, pre[m][bj][0]); h1 = __builtin_bit_cast(f32x4, pre[m][bj][1]); } else unpack8(pre[m][bj][0], pre[m][bj][1], h0, h1);
                    h0 = h0 + acc[ai][bj][m][0]; h1 = h1 + acc[ai][bj][m][1];
                    if (MODE == 2) { *(f32x4*)(out + off + bj * HALF) = h0; *(f32x4*)(out + off + bj * HALF + 4) = h1; }
                    else { q += ((h0[0] * h0[0] + h0[1] * h0[1]) + (h0[2] * h0[2] + h0[3] * h0[3])) + ((h1[0] * h1[0] + h1[1] * h1[1]) + (h1[2] * h1[2] + h1[3] * h1[3]));
                        u32x4 w; w.x = cvt_pk_bf16(h0[0], h0[1]); w.y = cvt_pk_bf16(h0[2], h0[3]); w.z = cvt_pk_bf16(h1[0], h1[1]); w.w = cvt_pk_bf16(h1[2], h1[3]);
                        u32x4 l; l.x = cvt_pk_bf16(h0[0] - __builtin_bit_cast(float, w.x << 16), h0[1] - __builtin_bit_cast(float, w.x & 0xffff0000u)); l.y = cvt_pk_bf16(h0[2] - __builtin_bit_cast(float, w.y << 16), h0[3] - __builtin_bit_cast(float, w.y & 0xffff0000u));
                        l.z = cvt_pk_bf16(h1[0] - __builtin_bit_cast(float, w.z << 16), h1[1] - __builtin_bit_cast(float, w.z & 0xffff0000u)); l.w = cvt_pk_bf16(h1[2] - __builtin_bit_cast(float, w.w << 16), h1[3] - __builtin_bit_cast(float, w.w & 0xffff0000u));
                        *(u32x4*)(xb + off + bj * HALF) = w; *(u32x4*)(xl + off + bj * HALF) = l; } }
                if (MODE != 2) { q += __shfl_xor(q, 16); q += __shfl_xor(q, 32);
                    if (fq == 0) atomicAdd(ssq + row, q); } }
            asm volatile("" ::: "memory");
        }
    }
};
typedef EpiResT<0> EpiRes0;
typedef EpiResT<1> EpiRes1;
typedef EpiResT<2> EpiRes2;

template <class Epi, class Sched, bool ALIGN_EPI = false, bool SP2 = false>
__device__ __forceinline__ void gemm_phase(PG8_LAS unsigned char* lds, const Gemm g, const Sched& S, const Epi& E, const float* rowss = nullptr, PG8_LAS float* aux = nullptr) {
    const int tid = threadIdx.x, wid = __builtin_amdgcn_readfirstlane(tid >> 6), lane = tid & 63, wr = wid >> 2, wc = wid & 3, fr = lane & 15, fq = lane >> 4;
    const int K = g.K, nt = K / BK, lda = g.lda;
    unsigned voffA[2], voffB[2];
#pragma unroll
    for (int i = 0; i < 2; ++i) { int R, C; stage_rc(tid * 16 + i * 8192, R, C); const int Rb = Epi::PERM ? ((R & ~31) + perm32(R & 31)) : R;
        voffA[i] = (unsigned)(R * lda + C) * 2u; voffB[i] = (unsigned)(Rb * K + C) * 2u; }
    const size_t kstep = (size_t)(BK * 2);
    const size_t hstepA = (size_t)HALF * lda * 2, hstepB = (size_t)HALF * K * 2;
    const size_t tstepA = 2 * hstepA, tstepB = 2 * hstepB;
    const unsigned ldsw = (unsigned)wid * 1024u;
    const int aoff = lds_byte(wr * 64 + fr, fq * 8), boff = lds_byte(wc * 32 + fr, fq * 8);
#define PG8_SA(b, h) (((b) * 2 + (h)) * HTB)
#define PG8_SB(b, h) ((4 + (b) * 2 + (h)) * HTB)
#define PG8_STAGE(bufoff, gbase, voff) do { _Pragma("unroll") for (int _i = 0; _i < 2; ++_i) \
        __builtin_amdgcn_global_load_lds((const unsigned*)((const char*)(gbase) + (voff)[_i]), (PG8_LAS unsigned*)(lds + (bufoff) + ldsw + _i * 8192), 16, 0, 0); } while (0)
#define PG8_LDA(dst, b, h) do { _Pragma("unroll") for (int m = 0; m < 4; ++m) _Pragma("unroll") for (int k = 0; k < 2; ++k) dst[m][k] = *(const PG8_LAS bf16x8*)(lds + PG8_SA(b, h) + aoff + m * 2048 + k * 1024); } while (0)
#define PG8_LDB(dst, b, h) do { _Pragma("unroll") for (int n = 0; n < 2; ++n) _Pragma("unroll") for (int k = 0; k < 2; ++k) dst[n][k] = *(const PG8_LAS bf16x8*)(lds + PG8_SB(b, h) + boff + n * 2048 + k * 1024); } while (0)
#define PG8_MMA(ai, bj, At, Bt) do { __builtin_amdgcn_s_setprio(1); _Pragma("unroll") for (int m = 0; m < 4; ++m) _Pragma("unroll") for (int n = 0; n < 2; ++n) _Pragma("unroll") for (int k = 0; k < 2; ++k) \
        acc[ai][bj][m][n] = __builtin_amdgcn_mfma_f32_16x16x32_bf16(Bt[n][k], At[m][k], acc[ai][bj][m][n], 0, 0, 0); __builtin_amdgcn_s_setprio(0); } while (0)
#define PG8_WAIT_V(n) asm volatile("s_waitcnt vmcnt(" #n ")" ::: "memory")
#define PG8_WAIT_L(n) asm volatile("s_waitcnt lgkmcnt(" #n ")" ::: "memory")
#define PG8_BAR __builtin_amdgcn_s_barrier()
#define PG8_SCHED __builtin_amdgcn_sched_barrier(0)
    Unit cur, nxt; int ui = 0;
    if (!S.next(0, cur)) return;
    f32x4 acc[2][2][4][2];
#pragma unroll
    for (int a = 0; a < 2; ++a)
#pragma unroll
        for (int b = 0; b < 2; ++b)
#pragma unroll
            for (int m = 0; m < 4; ++m)
#pragma unroll
                for (int n = 0; n < 2; ++n) acc[a][b][m][n] = (f32x4){0.f, 0.f, 0.f, 0.f};
    bf16x8 At[4][2], B0[2][2], B1[2][2];
    const char* cA = (const char*)g.A + (size_t)cur.pm * tstepA; const char* cB = (const char*)g.Bt + (size_t)cur.pn * tstepB;
    if (rowss && tid < 256) aux[tid] = __builtin_amdgcn_rsqf(rowss[cur.pm * BM + tid] * (1.0f / 1024.0f) + 1e-5f);
    if constexpr (SP2) {
        PG8_STAGE(PG8_SB(0, 0), cB, voffB); PG8_STAGE(PG8_SB(0, 1), cB + hstepB, voffB); PG8_STAGE(PG8_SA(0, 0), cA, voffA); PG8_STAGE(PG8_SA(0, 1), cA + hstepA, voffA);
        if (wr == 1) PG8_BAR;
        PG8_WAIT_V(2); PG8_BAR;
        PG8_STAGE(PG8_SB(1, 0), cB + kstep, voffB); PG8_STAGE(PG8_SA(1, 0), cA + kstep, voffA); PG8_STAGE(PG8_SB(1, 1), cB + hstepB + kstep, voffB);
        PG8_WAIT_V(6); PG8_BAR;
    } else {
        PG8_STAGE(PG8_SB(0, 0), cB, voffB); PG8_STAGE(PG8_SA(0, 0), cA, voffA); PG8_STAGE(PG8_SB(0, 1), cB + hstepB, voffB); PG8_STAGE(PG8_SA(0, 1), cA + hstepA, voffA);
        if (wr == 1) PG8_BAR;
        PG8_WAIT_V(4); PG8_BAR;
        PG8_STAGE(PG8_SB(1, 0), cB + kstep, voffB); PG8_STAGE(PG8_SA(1, 0), cA + kstep, voffA); PG8_STAGE(PG8_SB(1, 1), cB + hstepB + kstep, voffB);
        PG8_WAIT_V(6); PG8_BAR;
    }
    for (;;) {
        const bool has_next = S.next(ui + 1, nxt);
        const char* nA = has_next ? (const char*)g.A + (size_t)nxt.pm * tstepA : cA; const char* nB = has_next ? (const char*)g.Bt + (size_t)nxt.pn * tstepB : cB;
        for (int t = 0; t < nt; t += 2) {
            const bool last = (t == nt - 2);
            const char* a1 = cA + (size_t)(t + 1) * kstep;
            const char* a2 = last ? nA : cA + (size_t)(t + 2) * kstep; const char* b2 = last ? nB : cB + (size_t)(t + 2) * kstep;
            const char* a3 = a2 + kstep; const char* b3 = b2 + kstep;
            if constexpr (SP2) {
            PG8_LDB(B0, 0, 0); PG8_LDB(B1, 0, 1); PG8_SCHED; PG8_LDA(At, 0, 0); PG8_STAGE(PG8_SA(1, 1), a1 + hstepA, voffA);
            PG8_WAIT_V(8); PG8_WAIT_L(0); PG8_BAR; PG8_MMA(0, 0, At, B0); PG8_MMA(0, 1, At, B1); PG8_BAR; PG8_SCHED;
            PG8_LDA(At, 0, 1); PG8_STAGE(PG8_SB(0, 0), b2, voffB); PG8_STAGE(PG8_SB(0, 1), b2 + hstepB, voffB); PG8_STAGE(PG8_SA(0, 0), a2, voffA);
            PG8_WAIT_V(8); PG8_WAIT_L(0); PG8_BAR; PG8_MMA(1, 0, At, B0); PG8_MMA(1, 1, At, B1); PG8_BAR; PG8_SCHED;
            PG8_LDB(B0, 1, 0); PG8_LDB(B1, 1, 1); PG8_SCHED; PG8_LDA(At, 1, 0); PG8_STAGE(PG8_SA(0, 1), a2 + hstepA, voffA);
            PG8_WAIT_V(8); PG8_WAIT_L(0); PG8_BAR; PG8_MMA(0, 0, At, B0); PG8_MMA(0, 1, At, B1); PG8_BAR; PG8_SCHED;
            PG8_LDA(At, 1, 1); PG8_STAGE(PG8_SB(1, 0), b3, voffB); PG8_STAGE(PG8_SB(1, 1), b3 + hstepB, voffB); PG8_STAGE(PG8_SA(1, 0), a3, voffA);
            PG8_WAIT_V(8); PG8_WAIT_L(0); PG8_BAR; PG8_MMA(1, 0, At, B0); PG8_MMA(1, 1, At, B1); PG8_BAR; PG8_SCHED;
            } else {
            PG8_LDB(B0, 0, 0); PG8_SCHED; PG8_LDA(At, 0, 0); PG8_STAGE(PG8_SA(1, 1), a1 + hstepA, voffA);
            PG8_WAIT_L(8); PG8_BAR; PG8_WAIT_L(0); PG8_MMA(0, 0, At, B0); PG8_BAR; PG8_SCHED;
            PG8_LDB(B1, 0, 1); PG8_STAGE(PG8_SB(0, 0), b2, voffB);
            PG8_BAR; PG8_WAIT_L(0); PG8_MMA(0, 1, At, B1); PG8_BAR;
            PG8_LDA(At, 0, 1); PG8_STAGE(PG8_SA(0, 0), a2, voffA);
            PG8_BAR; PG8_WAIT_L(0); PG8_MMA(1, 0, At, B0); PG8_BAR; PG8_SCHED;
            PG8_STAGE(PG8_SB(0, 1), b2 + hstepB, voffB);
            PG8_WAIT_V(6); PG8_BAR; PG8_MMA(1, 1, At, B1); PG8_BAR;
            PG8_LDB(B0, 1, 0); PG8_SCHED; PG8_LDA(At, 1, 0); PG8_STAGE(PG8_SA(0, 1), a2 + hstepA, voffA);
            PG8_WAIT_L(8); PG8_BAR; PG8_WAIT_L(0); PG8_MMA(0, 0, At, B0); PG8_BAR; PG8_SCHED;
            PG8_LDB(B1, 1, 1); PG8_STAGE(PG8_SB(1, 0), b3, voffB);
            PG8_BAR; PG8_WAIT_L(0); PG8_MMA(0, 1, At, B1); PG8_BAR;
            PG8_LDA(At, 1, 1); PG8_STAGE(PG8_SA(1, 0), a3, voffA);
            PG8_BAR; PG8_WAIT_L(0); PG8_MMA(1, 0, At, B0); PG8_BAR; PG8_SCHED;
            PG8_STAGE(PG8_SB(1, 1), b3 + hstepB, voffB);
            PG8_WAIT_V(6); PG8_BAR; PG8_MMA(1, 1, At, B1); PG8_BAR;
            }
        }
        if constexpr (ALIGN_EPI) { if (wr == 0) PG8_BAR; }
        E(acc, cur, wr, wc, fr, fq, aux + (ui & 1) * 256);
        if (!has_next) break;
#pragma unroll
        for (int a = 0; a < 2; ++a)
#pragma unroll
            for (int b = 0; b < 2; ++b)
#pragma unroll
                for (int m = 0; m < 4; ++m)
#pragma unroll
                    for (int n = 0; n < 2; ++n) acc[a][b][m][n] = (f32x4){0.f, 0.f, 0.f, 0.f};
        cur = nxt; cA = nA; cB = nB; ++ui;
        if (rowss && tid < 256) aux[(ui & 1) * 256 + tid] = __builtin_amdgcn_rsqf(rowss[cur.pm * BM + tid] * (1.0f / 1024.0f) + 1e-5f);
        if constexpr (ALIGN_EPI) { if (wr == 1) PG8_BAR; }
    }
    PG8_WAIT_V(0);
    if constexpr (!ALIGN_EPI) { if (wr == 0) PG8_BAR; }
    PG8_BAR;
#undef PG8_SA
#undef PG8_SB
#undef PG8_STAGE
#undef PG8_LDA
#undef PG8_LDB
#undef PG8_MMA
#undef PG8_WAIT_V
#undef PG8_WAIT_L
#undef PG8_BAR
#undef PG8_SCHED
}
}
constexpr int NWAVES = 8;
constexpr int BATCH = 8, SEQ = 4096, DM = 1024, FF = 4096, M = BATCH * SEQ;
constexpr int N0 = 2816, N0G = 3072, N0SRC = 2840, N1 = 3072, N1SRC = 3088;
constexpr int C_MQ = 0, C_MK = 512, C_MV = 1024, C_NQ = 1536, C_KSL = 2304, C_VSL = 2432, C_KWN = 2560, C_VWN = 2688;
constexpr int C_FQ = 0, C_FK = 1024, C_FV = 2048;
constexpr float LOG2E = 1.4426950408889634f;
constexpr float C2 = 0.125f * LOG2E;

constexpr size_t MiB = 1u << 20;
constexpr size_t WS_CTL = 0, CTL_ZERO_BYTES = 1 * MiB;
constexpr size_t WS_WIN0 = 1 * MiB;
constexpr size_t WS_WOUT0 = WS_WIN0 + (size_t)N0G * 1024 * 2;
constexpr size_t WS_W1_0 = WS_WOUT0 + 2 * MiB;
constexpr size_t WS_W2_0 = WS_W1_0 + 8 * MiB;
constexpr size_t WS_WIN1 = WS_W2_0 + 8 * MiB;
constexpr size_t WS_WOUT1 = WS_WIN1 + 6 * MiB;
constexpr size_t WS_W1_1 = WS_WOUT1 + 2 * MiB;
constexpr size_t WS_W2_1 = WS_W1_1 + 8 * MiB;
constexpr size_t WS_WCMP = WS_W2_1 + 8 * MiB;
constexpr size_t WS_WG0 = WS_WCMP + 2 * MiB;
constexpr size_t WS_WF1 = WS_WG0 + 65536;
constexpr size_t WS_TB = WS_WF1 + 65536;
constexpr size_t WS_POSB = WS_TB + 65536;
constexpr size_t WS_W2T = WS_POSB + 4096;
constexpr size_t WS_SSQ = WS_W2T + 65536;
constexpr size_t WS_KMEAN = WS_SSQ + 4 * (size_t)M * 4;
constexpr size_t WS_MSEL = WS_KMEAN + 8 * 8 * 16 * 64 * 4;
constexpr size_t WS_SSEL = WS_MSEL + 8 * 8 * 4096 * 4;
constexpr size_t WS_GZ = WS_SSEL + 8 * 2 * 4096 * 8;
constexpr size_t WS_CK = WS_GZ + (size_t)M * 32 * 4;
constexpr size_t WS_CMPIN = WS_CK + 8 * 16 * 4096 * 4;
constexpr size_t WS_HID = WS_CMPIN + 2 * 16 * 4096 * 64 * 2 + 65536;
constexpr size_t WS_KVCMP = WS_HID + 8192 * 256 * 2;
constexpr size_t WS_OCMP = ((WS_KVCMP + 2 * 16 * 256 * 64 * 2 + MiB - 1) / MiB) * MiB;
constexpr size_t WS_KNT = WS_MSEL;
constexpr size_t WS_RT = WS_MSEL + 65536;
constexpr size_t WS_XL = WS_OCMP;
constexpr size_t WS_XB = WS_OCMP + (size_t)M * 512 * 4;
constexpr size_t WS_P = WS_XB + (size_t)M * 1024 * 2;
constexpr size_t WS_O = WS_P + (size_t)M * 3072 * 2;
constexpr size_t WS_A = WS_P;
constexpr size_t WS_END = WS_O + (size_t)M * 1024 * 2;
constexpr int CW_BAR = 4096, CW_QFOX = 8192, CW_QMOBA = 8256, CW_QNSA = 8320, CW_CMPDONE = 8384;

constexpr int RING_OFF = 0, RING_BYTES = 143360;
constexpr int LDSCTL_OFF = RING_BYTES, MISC_OFF = LDSCTL_OFF + 320;
constexpr int LDS_BYTES = 147456;

#define GAS __attribute__((address_space(1)))
#define LAS __attribute__((address_space(3)))
typedef unsigned short bf16;
typedef unsigned v4u __attribute__((ext_vector_type(4)));
typedef float f32x4 __attribute__((ext_vector_type(4)));
typedef float f32x16 __attribute__((ext_vector_type(16)));
typedef short bf16x8 __attribute__((ext_vector_type(8)));
typedef GAS unsigned gu32;
#define RLX_AGENT __ATOMIC_RELAXED, __HIP_MEMORY_SCOPE_AGENT
#define LDS_WAIT() asm volatile("s_waitcnt lgkmcnt(0)" ::: "memory")
#define VM_WAIT() asm volatile("s_waitcnt vmcnt(0)" ::: "memory")
__device__ __forceinline__ unsigned f2bf(float f) { unsigned u = __builtin_bit_cast(unsigned, f); return (u + 0x7fffu + ((u >> 16) & 1u)) >> 16; }
__device__ __forceinline__ unsigned pk2(float lo, float hi) { return f2bf(lo) | (f2bf(hi) << 16); }
__device__ __forceinline__ float bflo(unsigned w) { return __builtin_bit_cast(float, w << 16); }
__device__ __forceinline__ float bfhi(unsigned w) { return __builtin_bit_cast(float, w & 0xffff0000u); }
__device__ __forceinline__ float bf2f(bf16 h) { return __builtin_bit_cast(float, (unsigned)h << 16); }

#define XB_TMO      128
#define XB_XCNT(j)  (256  + 64 * (j))
#define XB_XSUB(j)  (1280 + 64 * (j))
#define XB_XGEN(j)  (2304 + 64 * (j))
#define XB_TOP      3328
#define XB_TOPGEN   3392
#define XCD_BAR_WORDS 3456
#define XB_SPIN_CAP (1u << 20)
__device__ __forceinline__ unsigned xb_ld(unsigned* p)              { return __hip_atomic_load(p, __ATOMIC_RELAXED, __HIP_MEMORY_SCOPE_AGENT); }
__device__ __forceinline__ unsigned xb_add(unsigned* p, unsigned v) { return __hip_atomic_fetch_add(p, v, __ATOMIC_RELAXED, __HIP_MEMORY_SCOPE_AGENT); }
__device__ __forceinline__ unsigned xb_xcc_id() { return (unsigned)__builtin_amdgcn_s_getreg((3 << 11) | 20) & 0xFu; }
#define XB_SPIN(cond, bar) do { unsigned _sp = 0; while (cond) { __builtin_amdgcn_s_sleep(1); \
    if ((++_sp & 255u) == 0u) { if (xb_ld(&(bar)[XB_TMO])) break; if (_sp > XB_SPIN_CAP) { atomicAdd(&(bar)[XB_TMO], 1u); break; } } } } while (0)
struct XcdBarrier { unsigned* bar; unsigned x; volatile LAS unsigned* st; };
__device__ __forceinline__ XcdBarrier xcd_barrier_post(unsigned* bar, volatile LAS unsigned* st) {
    XcdBarrier b; b.bar = bar; b.x = xb_xcc_id(); b.st = st;
    if (threadIdx.x == 0) (void)xb_add(&bar[XB_XCNT(b.x)], 1u);
    return b;
}
__device__ __forceinline__ void xcd_barrier_complete(unsigned* bar, unsigned x, unsigned& nloc, unsigned& nx) {
    const unsigned G = gridDim.x * gridDim.y * gridDim.z;
    unsigned sum, cnt, mine, sp = 0u;
    for (;;) {
        sum = 0u; cnt = 0u; mine = 0u;
#pragma unroll
        for (unsigned j = 0; j < 16; ++j) { const unsigned c = xb_ld(&bar[XB_XCNT(j)]); sum += c; cnt += (c > 0u) ? 1u : 0u; mine = (j == x) ? c : mine; }
        if (sum == G) break;
        __builtin_amdgcn_s_sleep(1);
        if ((++sp & 255u) == 0u) { if (xb_ld(&bar[XB_TMO])) break; if (sp > XB_SPIN_CAP) { atomicAdd(&bar[XB_TMO], 1u); break; } }
    }
    nloc = mine > 0u ? mine : 1u; nx = cnt > 0u ? cnt : 1u;
}
__device__ __forceinline__ void xcd_barrier(const XcdBarrier& b) {
    asm volatile("s_waitcnt vmcnt(0)" ::: "memory");
    __syncthreads();
    if (threadIdx.x == 0) {
        unsigned* bar = b.bar;
        __builtin_amdgcn_s_waitcnt(0);
        unsigned nloc = b.st[0], nx = b.st[1];
        if (nloc == 0u) { xcd_barrier_complete(bar, b.x, nloc, nx); b.st[0] = nloc; b.st[1] = nx; }
        const unsigned old = xb_add(&bar[XB_XSUB(b.x)], 1u);
        const unsigned gen = old / nloc;
        if (old + 1u == (gen + 1u) * nloc) {
            __builtin_amdgcn_fence(__ATOMIC_RELEASE, "agent");
            asm volatile("s_waitcnt vmcnt(0)" ::: "memory");
            const unsigned og = xb_add(&bar[XB_TOP], 1u);
            const unsigned tg = og / nx;
            if (og + 1u == (tg + 1u) * nx) xb_add(&bar[XB_TOPGEN], 1u);
            else XB_SPIN(xb_ld(&bar[XB_TOPGEN]) == tg, bar);
            __builtin_amdgcn_fence(__ATOMIC_ACQUIRE, "agent");
            xb_add(&bar[XB_XGEN(b.x)], 1u);
            asm volatile("s_waitcnt vmcnt(0)" ::: "memory");
        } else {
            XB_SPIN(xb_ld(&bar[XB_XGEN(b.x)]) == gen, bar);
            __builtin_amdgcn_fence(__ATOMIC_ACQUIRE, "agent");
            asm volatile("s_waitcnt vmcnt(0)" ::: "memory");
        }
    }
    __syncthreads();
}

struct Frame {
    LAS unsigned char* lds;
    volatile LAS unsigned* MISC;
    gu32* ctl;
    int tid, lane, wave;
    int vcu, G;
    int gw, NGW;
    unsigned char* ws;
};

__device__ __forceinline__ float wave_sum(float v) {
#pragma unroll
    for (int o = 1; o < 64; o <<= 1) v += __shfl_xor(v, o);
    return v;
}
__device__ __forceinline__ float wave_max(float v) {
#pragma unroll
    for (int o = 1; o < 64; o <<= 1) v = fmaxf(v, __shfl_xor(v, o));
    return v;
}
struct TrItem { const float* W; int K, Nsrc, Nuse; const float* gk; bf16* WT; int row_off, item; };
__device__ __forceinline__ void tr_load(const TrItem& d, int lane, f32x4 (&v)[8]) {
    const int nblk = d.Nuse / 32, kb = d.item / nblk, nb = d.item % nblk, k0 = 64 * kb, n0 = 32 * nb;
#pragma unroll
    for (int i = 0; i < 8; ++i) { const int kk = 8 * i + (lane >> 3); v[i] = *(const f32x4*)(d.W + (size_t)(k0 + kk) * d.Nsrc + n0 + 4 * (lane & 7)); if (d.gk) v[i] = v[i] * d.gk[k0 + kk]; }
}
__device__ __forceinline__ void tr_finish(const TrItem& d, int lane, const f32x4 (&v)[8], LAS float* scr) {
    const int nblk = d.Nuse / 32, kb = d.item / nblk, nb = d.item % nblk, k0 = 64 * kb, n0 = 32 * nb;
#pragma unroll
    for (int i = 0; i < 8; ++i) { const int kk = 8 * i + (lane >> 3); LAS float* t = scr + kk * 33 + 4 * (lane & 7); t[0] = v[i].x; t[1] = v[i].y; t[2] = v[i].z; t[3] = v[i].w; }
    LDS_WAIT(); asm volatile("" ::: "memory");
    const int c = lane & 7;
#pragma unroll
    for (int j = 0; j < 4; ++j) { const int n = (lane >> 3) + 8 * j; const LAS float* s = scr + (8 * c) * 33 + n;
        v4u o; o.x = pk2(s[0 * 33], s[1 * 33]); o.y = pk2(s[2 * 33], s[3 * 33]); o.z = pk2(s[4 * 33], s[5 * 33]); o.w = pk2(s[6 * 33], s[7 * 33]);
        *(GAS v4u*)(d.WT + (size_t)(d.row_off + n0 + n) * d.K + k0 + 8 * c) = o; }
    LDS_WAIT(); asm volatile("" ::: "memory");
}
__device__ __forceinline__ int t5_bucket(int d) {
    if (d < 16) return d;
    int b = 16;
    b += (d >= 21); b += (d >= 27); b += (d >= 35); b += (d >= 46); b += (d >= 59); b += (d >= 77); b += (d >= 99); b += (d >= 128);
    b += (d >= 166); b += (d >= 216); b += (d >= 280); b += (d >= 363); b += (d >= 470); b += (d >= 609); b += (d >= 790);
    return b;
}
struct Args { const float* in[18]; float* out; unsigned char* ws; int ph_lo, ph_hi; };
template <int BYTE_OFF> __device__ __forceinline__ const float* karg() {
    const char* ka = (const char*)__builtin_amdgcn_kernarg_segment_ptr(); unsigned long long v;
    asm volatile("s_load_dwordx2 %0, %1, %2\n\ts_waitcnt lgkmcnt(0)" : "=s"(v) : "s"(ka), "i"(BYTE_OFF));
    return (const float*)v;
}
#define KIN(k) karg<8 * (k)>()
#define KOUT() ((float*)karg<8 * 18>())
enum { I_X = 0, I_RELB, I_MIXN, I_MLPN, I_EWIN, I_EWOUT, I_POSK, I_POSV, I_CKW1, I_CKW2, I_CVW1, I_CVW2, I_OWIN, I_OBF, I_OWOUT, I_MW1, I_MW2, I_FN };

__device__ __forceinline__ void p0_prologue(Frame& F, const Args& a) {
    unsigned char* ws = F.ws;
    auto stream_x = [&](int m0, int m1, int xw, int NXW) __attribute__((always_inline)) {
#pragma unroll 1
        for (int m = m0 + xw; m < m1; m += 4 * NXW) {
            f32x4 v[4][4];
#pragma unroll
            for (int q = 0; q < 4; ++q) { const int mm = (m + q * NXW < m1) ? m + q * NXW : m; const GAS f32x4* xr = (const GAS f32x4*)(KIN(I_X) + (size_t)mm * 1024) + F.lane;
#pragma unroll
                for (int j = 0; j < 4; ++j) v[q][j] = __builtin_nontemporal_load(xr + 64 * j); }
            asm volatile("" ::: "memory");
#pragma unroll
            for (int q = 0; q < 4; ++q) { const int mm = m + q * NXW; if (mm < m1) {
                GAS unsigned long long* o8 = (GAS unsigned long long*)((bf16*)(ws + WS_XB) + (size_t)mm * 1024) + F.lane; float s = 0.f;
#pragma unroll
                for (int j = 0; j < 4; ++j) { const f32x4 w = v[q][j]; s += (w.x * w.x + w.y * w.y) + (w.z * w.z + w.w * w.w);
                    o8[64 * j] = (unsigned long long)pk2(w.x, w.y) | ((unsigned long long)pk2(w.z, w.w) << 32); }
                s = wave_sum(s); if (F.lane == 0) ((float*)(ws + WS_SSQ))[mm] = s; } }
        }
    };
    constexpr int M_MAIN = M;
    if (F.wave < 6) { stream_x(0, M_MAIN, F.vcu * 6 + F.wave, F.G * 6); return; }
    const int sw = F.vcu * 2 + (F.wave - 6), NSW = F.G * 2;
    LAS float* scr = (LAS float*)(F.lds + RING_OFF + F.wave * 16384);
    constexpr int I_IN0 = 16 * (N0 / 32), I_CW = 32 * 8;
    auto p0_item = [&](int r) __attribute__((always_inline)) -> TrItem {
        if (r < I_IN0) return TrItem{KIN(I_EWIN), 1024, N0SRC, N0, KIN(I_MIXN), (bf16*)(ws + WS_WIN0), 0, r};
        r -= I_IN0;
        if (r < I_CW) return TrItem{KIN(I_CKW1), 2048, 256, 256, nullptr, (bf16*)(ws + WS_WCMP), 0, r};
        return TrItem{KIN(I_CVW1), 2048, 256, 256, nullptr, (bf16*)(ws + WS_WCMP), 256, r - I_CW}; };
    for (int it = sw; it < I_IN0 + 2 * I_CW; it += 2 * NSW) {
        const bool two = it + NSW < I_IN0 + 2 * I_CW;
        const TrItem d0 = p0_item(it), d1 = p0_item(two ? it + NSW : it);
        f32x4 v0[8], v1[8]; tr_load(d0, F.lane, v0); if (two) tr_load(d1, F.lane, v1);
        asm volatile("" ::: "memory");
        tr_finish(d0, F.lane, v0, scr); if (two) tr_finish(d1, F.lane, v1, scr);
    }
    const int gt = sw * 64 + F.lane, NGT = NSW * 64;
    for (int i0 = gt; i0 < 256 * 1024; i0 += 8 * NGT) { float v[8];
#pragma unroll
        for (int q = 0; q < 8; ++q) { const int i = i0 + q * NGT, n = i >> 10, k = i & 1023; v[q] = 0.f;
            if (i < 256 * 1024 && n < 24) v[q] = KIN(I_EWIN)[(size_t)k * N0SRC + N0 + n] * KIN(I_MIXN)[k]; }
        asm volatile("" ::: "memory");
#pragma unroll
        for (int q = 0; q < 8; ++q) { const int i = i0 + q * NGT, n = i >> 10, k = i & 1023;
            if (i < 256 * 1024) ((bf16*)(ws + WS_WIN0))[(size_t)(N0 + n) * 1024 + k] = (bf16)f2bf(v[q]); } }
    for (int i = gt; i < 32 * 1024; i += NGT) { const int n = i >> 10, k = i & 1023; float v = 0.f;
        if (n < 16) v = KIN(I_OWIN)[(size_t)k * N1SRC + N1 + n] * KIN(I_MIXN)[1024 + k];
        ((bf16*)(ws + WS_WF1))[n * 1024 + k] = (bf16)f2bf(v); }
    for (int i = gt; i < 8 * 8 * 16 * 64; i += NGT) ((float*)(ws + WS_KMEAN))[i] = 0.f;
    for (int i = gt; i < 2 * 64 * 256; i += NGT) { const int w = i >> 14, d = (i >> 8) & 63, cc = i & 255; ((bf16*)(ws + WS_W2T))[i] = (bf16)f2bf((w ? KIN(I_CVW2) : KIN(I_CKW2))[cc * 64 + d]); }
    for (int i = gt; i < 16 * 1024; i += NGT) { const int h = i >> 10, d = i & 1023; ((float*)(ws + WS_TB))[i] = KIN(I_RELB)[t5_bucket(d) * 16 + h] * LOG2E; }
    for (int i = gt; i < 16 * 1280; i += NGT) { const int h = i / 1280, j = i - h * 1280; ((float*)(ws + WS_RT))[i] = (j < 1024) ? KIN(I_RELB)[t5_bucket(1023 - j) * 16 + h] * LOG2E : 0.f; }
    for (int i = NSW - 1 - sw; i < 512; i += NSW) { const int w = i >> 8, c = i & 255; const float* pos = (w ? KIN(I_POSV) : KIN(I_POSK)); const float* W1 = (w ? KIN(I_CVW1) : KIN(I_CKW1)); float s = 0.f;
#pragma unroll 8
        for (int k = 0; k < 32; ++k) s += pos[32 * F.lane + k] * W1[(size_t)(32 * F.lane + k) * 256 + c];
        s = wave_sum(s); if (F.lane == 0) ((float*)(ws + WS_POSB))[i] = s; }
    for (int i = gt; i < 3 * M; i += NGT) ((float*)(ws + WS_SSQ))[M + i] = 0.f;
    stream_x(M_MAIN, M, sw, NSW);
}

constexpr int LATE_SQ = 16 * 32, LATE_UP = 16 * 128, LATE_DN = 64 * 32, LATE_IN1 = 16 * (N1 / 32);
constexpr int LATE_ITEMS = LATE_SQ + LATE_UP + LATE_DN + LATE_IN1 + LATE_SQ + LATE_UP + LATE_DN, LATE_CHUNKS = (LATE_ITEMS + 63) / 64;
__device__ __forceinline__ void late_weight_chunk(Frame& F, int chunk) {
    LAS float* scr = (LAS float*)(F.lds + RING_OFF + F.wave * 16384); unsigned char* ws = F.ws;
    auto late_item = [&](int r) __attribute__((always_inline)) -> TrItem {
        if (r < LATE_SQ) return TrItem{KIN(I_EWOUT), 1024, 1024, 1024, nullptr, (bf16*)(ws + WS_WOUT0), 0, r};
        r -= LATE_SQ;
        if (r < LATE_UP) return TrItem{KIN(I_MW1), 1024, 4096, 4096, KIN(I_MLPN), (bf16*)(ws + WS_W1_0), 0, r};
        r -= LATE_UP;
        if (r < LATE_DN) return TrItem{KIN(I_MW2), 4096, 1024, 1024, nullptr, (bf16*)(ws + WS_W2_0), 0, r};
        r -= LATE_DN;
        if (r < LATE_IN1) return TrItem{KIN(I_OWIN), 1024, N1SRC, N1, KIN(I_MIXN) + 1024, (bf16*)(ws + WS_WIN1), 0, r};
        r -= LATE_IN1;
        if (r < LATE_SQ) return TrItem{KIN(I_OWOUT), 1024, 1024, 1024, nullptr, (bf16*)(ws + WS_WOUT1), 0, r};
        r -= LATE_SQ;
        if (r < LATE_UP) return TrItem{KIN(I_MW1) + (size_t)1024 * 4096, 1024, 4096, 4096, KIN(I_MLPN) + 1024, (bf16*)(ws + WS_W1_1), 0, r};
        r -= LATE_UP;
        return TrItem{KIN(I_MW2) + (size_t)4096 * 1024, 4096, 1024, 1024, nullptr, (bf16*)(ws + WS_W2_1), 0, r}; };
#pragma unroll 1
    for (int k = 0; k < 8; k += 2) { const int r = chunk * 64 + F.wave * 8 + k; if (r >= LATE_ITEMS) break;
        const bool two = r + 1 < LATE_ITEMS;
        const TrItem d0 = late_item(r), d1 = late_item(two ? r + 1 : r);
        f32x4 v0[8], v1[8]; tr_load(d0, F.lane, v0); if (two) tr_load(d1, F.lane, v1);
        asm volatile("" ::: "memory");
        tr_finish(d0, F.lane, v0, scr); if (two) tr_finish(d1, F.lane, v1, scr); }
}
__device__ __forceinline__ void skinny_gemm(Frame& F, const bf16* A, const bf16* Wt, const float* ssq, float* out) {
    typedef float f32x4_t __attribute__((ext_vector_type(4)));
    const int r16 = F.lane & 15, kg = F.lane >> 4;
    for (int it = F.gw; it < M / 16; it += F.NGW) {
        const int row0 = it * 16; f32x4_t acc = {0.f, 0.f, 0.f, 0.f};
        const bf16* ap = A + (size_t)(row0 + r16) * 1024 + kg * 8; const bf16* bp = Wt + (size_t)r16 * 1024 + kg * 8;
#pragma unroll 8
        for (int ks = 0; ks < 32; ++ks) { const bf16x8 av = *(const bf16x8*)(ap + ks * 32), bv = *(const bf16x8*)(bp + ks * 32); acc = __builtin_amdgcn_mfma_f32_16x16x32_bf16(av, bv, acc, 0, 0, 0); }
#pragma unroll
        for (int r = 0; r < 4; ++r) { const int row = row0 + 4 * kg + r; out[(size_t)row * 32 + r16] = acc[r] * __builtin_amdgcn_rsqf(ssq[row] * (1.0f / 1024.0f) + 1e-5f); }
    }
}

__device__ __forceinline__ void ph_fox_cum(Frame& F, const Args& a) {
    const float* FZ = (const float*)(F.ws + WS_GZ); float* CK = (float*)(F.ws + WS_CK); LAS float* sc = (LAS float*)(F.lds + RING_OFF);
    for (int it = F.vcu; it < 128; it += F.G) { const int b = it >> 4, h = it & 15; const float bfv = KIN(I_OBF)[h];
        float v[8]; float run = 0.f;
#pragma unroll
        for (int k = 0; k < 8; ++k) { const int t = F.tid * 8 + k; const float z = FZ[(size_t)(b * 4096 + t) * 32 + h] + bfv;
            const float ls = fminf(z, 0.f) - log1pf(__expf(-fabsf(z))); run += ls; v[k] = run; }
        sc[F.tid] = run; __syncthreads();
        for (int off = 1; off < 512; off <<= 1) { float add = (F.tid >= off) ? sc[F.tid - off] : 0.f; __syncthreads(); sc[F.tid] += add; __syncthreads(); }
        const float base = (F.tid > 0) ? sc[F.tid - 1] : 0.f;
#pragma unroll
        for (int k = 0; k < 8; ++k) CK[(size_t)it * 4096 + F.tid * 8 + k] = (base + v[k]) * LOG2E;
        __syncthreads(); }
}
__device__ __forceinline__ void ph_final_norm(Frame& F, const Args& a) {
    const GAS f32x4* gr = (const GAS f32x4*)(KIN(I_FN)) + F.lane;
    f32x4 gn[4];
#pragma unroll
    for (int j = 0; j < 4; ++j) gn[j] = gr[64 * j];
#pragma unroll 1
    for (int m = F.gw; m < M; m += 4 * F.NGW) {
        f32x4 v[4][4];
#pragma unroll
        for (int q = 0; q < 4; ++q) { const int mm = (m + q * F.NGW < M) ? m + q * F.NGW : m; const GAS f32x4* xr = (const GAS f32x4*)(KOUT() + (size_t)mm * 1024) + F.lane;
#pragma unroll
            for (int j = 0; j < 4; ++j) v[q][j] = xr[64 * j]; }
        asm volatile("" ::: "memory");
#pragma unroll
        for (int q = 0; q < 4; ++q) { const int mm = m + q * F.NGW; if (mm < M) { GAS f32x4* xw = (GAS f32x4*)(KOUT() + (size_t)mm * 1024) + F.lane; float s = 0.f;
#pragma unroll
            for (int j = 0; j < 4; ++j) s += (v[q][j].x * v[q][j].x + v[q][j].y * v[q][j].y) + (v[q][j].z * v[q][j].z + v[q][j].w * v[q][j].w);
            const float rs = 1.0f / sqrtf(wave_sum(s) * (1.0f / 1024.0f) + 1e-5f);
#pragma unroll
            for (int j = 0; j < 4; ++j) xw[64 * j] = v[q][j] * rs * gn[j]; } }
    }
}
namespace fa {
typedef short s16x4 __attribute__((ext_vector_type(4)));
typedef short v4i16_t __attribute__((ext_vector_type(4)));
typedef unsigned u32x4 __attribute__((ext_vector_type(4)));
typedef LAS const char* lds_cptr;
constexpr int SLOTB = 8192;
constexpr int L_K = 0, L_V = 2 * SLOTB, L_WS = 4 * SLOTB, L_OST = L_WS + NWAVES * 64 * 4, L_TB = L_OST + NWAVES * 8192, TB_STRIDE = 1280, L_CK = L_TB, L_IMP = L_TB + 4 * TB_STRIDE * 4 + 2048, L_SEL = L_IMP + 2 * 65 * 32 * 4, L_END = L_SEL + 64 * 8;
static_assert(L_END <= RING_BYTES, "flash LDS map");
constexpr float MASKV = -30000.0f, THR = 8.0f;
__device__ __forceinline__ int crow(int r, int hi) { return (r & 3) + 8 * (r >> 2) + 4 * hi; }
__device__ __forceinline__ unsigned cvtpk(float lo, float hi) { typedef float f2 __attribute__((ext_vector_type(2))); typedef __bf16 b2 __attribute__((ext_vector_type(2))); f2 v = {lo, hi}; b2 b = __builtin_convertvector(v, b2); return __builtin_bit_cast(unsigned, b); }
__device__ __forceinline__ s16x4 vtr(lds_cptr p) { return __builtin_bit_cast(s16x4, __builtin_amdgcn_ds_read_tr16_b64_v4i16((LAS v4i16_t*)p)); }
#define FA_BAR() asm volatile("s_waitcnt vmcnt(0) lgkmcnt(0)\n\ts_barrier" ::: "memory")

struct Ctx { int lane, r32, hi, wid; LAS unsigned char* shm; };

__device__ __forceinline__ void dma_kv(const Ctx& c, const bf16* Kg, const bf16* Vg, int pitch, int k0, int slot) {
    const bf16* ks = Kg + (size_t)(k0 + 8 * c.wid + (c.lane >> 3)) * pitch + ((c.lane & 7) ^ (c.lane >> 3)) * 8;
    const bf16* vs = Vg + (size_t)(k0 + 16 * (c.wid & 3) + (c.lane >> 2)) * pitch + (c.wid >> 2) * 32 + (c.lane & 3) * 8;
    __builtin_amdgcn_global_load_lds((const unsigned*)ks, (LAS unsigned*)(c.shm + L_K + slot * SLOTB + c.wid * 1024), 16, 0, 0);
    __builtin_amdgcn_global_load_lds((const unsigned*)vs, (LAS unsigned*)(c.shm + L_V + slot * SLOTB + c.wid * 1024), 16, 0, 0);
}
__device__ __forceinline__ void load_q(bf16x8 (&qr)[4], const bf16* qrow, int hi) {
#pragma unroll
    for (int d0 = 0; d0 < 4; ++d0) qr[d0] = *(const bf16x8*)(qrow + d0 * 16 + hi * 8);
}
struct State { f32x16 o[2]; float m, l, mt; };
__device__ __forceinline__ void reset(State& s) { s.o[0] = f32x16{}; s.o[1] = f32x16{}; s.m = 0.f; s.l = 0.f; s.mt = -1.0e30f; }

__device__ __forceinline__ void dma_k(const Ctx& c, const bf16* Kg, int pitch, int k0, int slot) {
    const bf16* ks = Kg + (size_t)(k0 + 8 * c.wid + (c.lane >> 3)) * pitch + ((c.lane & 7) ^ (c.lane >> 3)) * 8;
    __builtin_amdgcn_global_load_lds((const unsigned*)ks, (LAS unsigned*)(c.shm + L_K + slot * SLOTB + c.wid * 1024), 16, 0, 0);
}
__device__ __forceinline__ void dma_v(const Ctx& c, const bf16* Vg, int pitch, int k0, int slot) {
    const bf16* vs = Vg + (size_t)(k0 + 16 * (c.wid & 3) + (c.lane >> 2)) * pitch + (c.wid >> 2) * 32 + (c.lane & 3) * 8;
    __builtin_amdgcn_global_load_lds((const unsigned*)vs, (LAS unsigned*)(c.shm + L_V + slot * SLOTB + c.wid * 1024), 16, 0, 0);
}
__device__ __forceinline__ void dma_copy(const Ctx& c, const float* src, int lds_off, int pieces) {
    for (int p = c.wid; p < pieces; p += NWAVES)
        __builtin_amdgcn_global_load_lds((const unsigned*)(src + p * 256 + c.lane * 4), (LAS unsigned*)(c.shm + lds_off + p * 1024), 16, 0, 0);
}
__device__ __forceinline__ void qk_tile(const Ctx& c, int slot, const bf16x8 (&qr)[4], f32x16& c0, f32x16& c1) {
    const lds_cptr kb = (lds_cptr)(c.shm + L_K + slot * SLOTB) + c.r32 * 128;
#pragma unroll
    for (int d0 = 0; d0 < 4; ++d0) { const int co = ((2 * d0 + c.hi) ^ (c.r32 & 7)) * 16; const bf16x8 b0 = *(const LAS bf16x8*)(kb + co), b1 = *(const LAS bf16x8*)(kb + 4096 + co);
        c0 = __builtin_amdgcn_mfma_f32_32x32x16_bf16(b0, qr[d0], c0, 0, 0, 0); c1 = __builtin_amdgcn_mfma_f32_32x32x16_bf16(b1, qr[d0], c1, 0, 0, 0); }
}
__device__ __forceinline__ float max3a(float a, float b, float c) { float r; asm("v_max3_f32 %0, %1, %2, %3" : "=v"(r) : "v"(a), "v"(b), "v"(c)); return r; }
template <bool HAS_NEXT, bool ASMMAX, class Pol>
__device__ __forceinline__ void fa_step(const Ctx& c, Pol& pol, const bf16x8 (&qr)[4], State& st, f32x16& c0, f32x16& c1, f32x16& n0, f32x16& n1, int t, int slot, LAS float* wsf) {
    pol.mask(c0, c1, t);
    float rm;
    if (ASMMAX) { float a = max3a(c0[0], c0[1], c1[0]), b = max3a(c0[2], c0[3], c1[1]); a = max3a(a, c1[2], c1[3]);
#pragma unroll
        for (int r = 4; r < 16; r += 4) { a = max3a(a, c0[r], c0[r + 1]); b = max3a(b, c0[r + 2], c0[r + 3]); a = max3a(a, c1[r], c1[r + 1]); b = max3a(b, c1[r + 2], c1[r + 3]); }
        rm = max3a(a, b, b); }
    else { rm = fmaxf(c0[0], c1[0]);
#pragma unroll
        for (int r = 1; r < 16; ++r) rm = fmaxf(rm, fmaxf(c0[r], c1[r])); }
    { auto rr = __builtin_amdgcn_permlane32_swap(__float_as_uint(rm), __float_as_uint(rm), false, false); rm = fmaxf(__uint_as_float(rr[0]), __uint_as_float(rr[1])); }
    if constexpr (Pol::TRACK) pol.track(st, rm, t);
    if (__any(rm > THR)) {
        const float dl = fmaxf(rm, 0.f); st.m += dl;
#pragma unroll
        for (int r = 0; r < 16; ++r) { c0[r] -= dl; c1[r] -= dl; }
        const float f = __builtin_amdgcn_exp2f(-dl); st.l *= f;
        if (c.hi == 0) wsf[c.r32] = f;
        LDS_WAIT();
#pragma unroll
        for (int r = 0; r < 16; ++r) { const float fr = wsf[crow(r, c.hi)]; st.o[0][r] *= fr; st.o[1][r] *= fr; }
        LDS_WAIT();
    }
    if (HAS_NEXT) { pol.init(n0, n1, st.m, t + 1); qk_tile(c, slot ^ 1, qr, n0, n1); }
    float sacc = 0.f;
    const lds_cptr vp = (lds_cptr)(c.shm + L_V + slot * SLOTB) + ((c.lane >> 4) & 1) * 32 + (c.lane & 3) * 8 + (4 * c.hi + ((c.lane & 15) >> 2)) * 64;
    u32x4 pw[4];
#pragma unroll
    for (int r = 0; r < 16; ++r) { c0[r] = __builtin_amdgcn_exp2f(c0[r]); sacc += c0[r]; }
    pw[0] = (u32x4){cvtpk(c0[0], c0[1]), cvtpk(c0[2], c0[3]), cvtpk(c0[4], c0[5]), cvtpk(c0[6], c0[7])};
    pw[1] = (u32x4){cvtpk(c0[8], c0[9]), cvtpk(c0[10], c0[11]), cvtpk(c0[12], c0[13]), cvtpk(c0[14], c0[15])};
#pragma unroll
    for (int ks = 0; ks < 2; ++ks)
#pragma unroll
        for (int d0 = 0; d0 < 2; ++d0) { const s16x4 lo = vtr(vp + d0 * 4096 + ks * 1024), hh = vtr(vp + d0 * 4096 + ks * 1024 + 512);
            const bf16x8 vf = (bf16x8){lo[0], lo[1], lo[2], lo[3], hh[0], hh[1], hh[2], hh[3]};
            st.o[d0] = __builtin_amdgcn_mfma_f32_32x32x16_bf16(__builtin_bit_cast(bf16x8, pw[ks]), vf, st.o[d0], 0, 0, 0); }
#pragma unroll
    for (int r = 0; r < 16; ++r) { c1[r] = __builtin_amdgcn_exp2f(c1[r]); sacc += c1[r]; }
    st.l += sacc;
    pw[2] = (u32x4){cvtpk(c1[0], c1[1]), cvtpk(c1[2], c1[3]), cvtpk(c1[4], c1[5]), cvtpk(c1[6], c1[7])};
    pw[3] = (u32x4){cvtpk(c1[8], c1[9]), cvtpk(c1[10], c1[11]), cvtpk(c1[12], c1[13]), cvtpk(c1[14], c1[15])};
#pragma unroll
    for (int ks = 2; ks < 4; ++ks)
#pragma unroll
        for (int d0 = 0; d0 < 2; ++d0) { const s16x4 lo = vtr(vp + d0 * 4096 + ks * 1024), hh = vtr(vp + d0 * 4096 + ks * 1024 + 512);
            const bf16x8 vf = (bf16x8){lo[0], lo[1], lo[2], lo[3], hh[0], hh[1], hh[2], hh[3]};
            st.o[d0] = __builtin_amdgcn_mfma_f32_32x32x16_bf16(__builtin_bit_cast(bf16x8, pw[ks]), vf, st.o[d0], 0, 0, 0); }
}
template <class Pol>
__device__ __forceinline__ void issue_first(const Ctx& c, const Pol& pol, const bf16* Kg, const bf16* Vg, int pitch) {
    dma_k(c, Kg, pitch, pol.k0(0), 0); dma_v(c, Vg, pitch, pol.k0(0), 0);
    if (pol.nt > 1) dma_k(c, Kg, pitch, pol.k0(1), 1);
}
template <bool PRE = false, class Pol>
__device__ __forceinline__ void run_branch(const Ctx& c, Pol& pol, const bf16* Kg, const bf16* Vg, int pitch, const bf16x8 (&qr)[4], State& st) {
    const int NT = pol.nt;
    if (NT <= 0) return;
    LAS float* wsf = (LAS float*)(c.shm + L_WS) + c.wid * 64;
    if (!PRE) issue_first(c, pol, Kg, Vg, pitch);
    FA_BAR();
    f32x16 a0, a1, b0, b1;
    pol.init(a0, a1, st.m, 0); qk_tile(c, 0, qr, a0, a1);
    FA_BAR();
    int t = 0;
    for (; t + 2 < NT; t += 2) {
        dma_k(c, Kg, pitch, pol.k0(t + 2), 0); dma_v(c, Vg, pitch, pol.k0(t + 1), 1);
        fa_step<true, true>(c, pol, qr, st, a0, a1, b0, b1, t, 0, wsf);
        FA_BAR();
        if (t + 3 < NT) dma_k(c, Kg, pitch, pol.k0(t + 3), 1);
        dma_v(c, Vg, pitch, pol.k0(t + 2), 0);
        fa_step<true, true>(c, pol, qr, st, b0, b1, a0, a1, t + 1, 1, wsf);
        FA_BAR();
    }
    if (t + 1 < NT) {
        dma_v(c, Vg, pitch, pol.k0(t + 1), 1);
        fa_step<true, true>(c, pol, qr, st, a0, a1, b0, b1, t, 0, wsf);
        FA_BAR();
        fa_step<false, true>(c, pol, qr, st, b0, b1, a0, a1, t + 1, 1, wsf);
        FA_BAR();
    } else {
        fa_step<false, true>(c, pol, qr, st, a0, a1, b0, b1, t, 0, wsf);
        FA_BAR();
    }
}
template <class Pol>
__device__ __forceinline__ void run_branch_simple(const Ctx& c, Pol& pol, const bf16* Kg, const bf16* Vg, int pitch, const bf16x8 (&qr)[4], State& st) {
    const int NT = pol.nt;
    if (NT <= 0) return;
    LAS float* wsf = (LAS float*)(c.shm + L_WS) + c.wid * 64;
    dma_kv(c, Kg, Vg, pitch, pol.k0(0), 0);
    FA_BAR();
    for (int i = 0; i < NT; ++i) {
        if (i + 1 < NT) dma_kv(c, Kg, Vg, pitch, pol.k0(i + 1), (i & 1) ^ 1);
        f32x16 c0, c1;
        pol.init(c0, c1, st.m, i); qk_tile(c, i & 1, qr, c0, c1);
        fa_step<false, false>(c, pol, qr, st, c0, c1, c0, c1, i, i & 1, wsf);
        FA_BAR();
    }
}
__device__ __forceinline__ void row_to_regs(const Ctx& c, float v, float (&out)[16]) {
    LAS float* wsf = (LAS float*)(c.shm + L_WS) + c.wid * 64;
    if (c.hi == 0) wsf[c.r32] = v;
    LDS_WAIT();
#pragma unroll
    for (int r = 0; r < 16; ++r) out[r] = wsf[crow(r, c.hi)];
    LDS_WAIT();
}
__device__ __forceinline__ float total_l(float l) { auto rr = __builtin_amdgcn_permlane32_swap(__float_as_uint(l), __float_as_uint(l), false, false); return __uint_as_float(rr[0]) + __uint_as_float(rr[1]); }
__device__ __forceinline__ void store_o(const Ctx& c, const f32x16 (&o)[2], bf16* orow0) {
    LAS bf16* stg = (LAS bf16*)(c.shm + L_OST + c.wid * 8192);
#pragma unroll
    for (int r = 0; r < 16; ++r) { const int orow = crow(r, c.hi);
#pragma unroll
        for (int d0 = 0; d0 < 2; ++d0) stg[orow * 64 + d0 * 32 + c.r32] = (bf16)f2bf(o[d0][r]); }
    LDS_WAIT();
#pragma unroll
    for (int i = 0; i < 4; ++i) { const int row = i * 8 + (c.lane >> 3), ch = c.lane & 7; const u32x4 v = *(const LAS u32x4*)(stg + row * 64 + ch * 8); *(u32x4*)(orow0 + (size_t)row * 1024 + ch * 8) = v; }
    LDS_WAIT();
}

constexpr int L_KNP = L_TB + 16384, L_WSM = L_KNP + 512;
constexpr float FOX_MARGIN = 32.0f;
struct FoxPol {
    static constexpr bool TRACK = true;
    static constexpr bool LOWREG = false;
    int nt; int qpos; int hi; int lane; int wid; float cq; float qn; LAS const float* ckl; LAS const float* knp; LAS float* wsm;
    __device__ __forceinline__ int k0(int i) const { return 64 * (nt - 1 - i); }
    __device__ __forceinline__ void init(f32x16& c0, f32x16& c1, float m, int i) const {
        const float base = cq - m; LAS const float* p = ckl + 64 * (nt - 1 - i) + 4 * hi;
#pragma unroll
        for (int g = 0; g < 4; ++g) { const f32x4 a = *(LAS const f32x4*)(p + 8 * g), b = *(LAS const f32x4*)(p + 32 + 8 * g);
#pragma unroll
            for (int e = 0; e < 4; ++e) { c0[4 * g + e] = base - a[e]; c1[4 * g + e] = base - b[e]; } }
    }
    __device__ __forceinline__ void mask(f32x16& c0, f32x16& c1, int i) const {
        if (i < 4) { const int kb = 64 * (nt - 1 - i) + 4 * hi;
#pragma unroll
            for (int r = 0; r < 16; ++r) { const int kv = kb + (r & 3) + 8 * (r >> 2); if (kv > qpos) c0[r] = MASKV; if (kv + 32 > qpos) c1[r] = MASKV; } }
    }
    __device__ __forceinline__ void track(State& st, float rm, int i) const {
        st.mt = fmaxf(st.mt, st.m + rm);
        if (i & 1) { float s = st.mt - cq - qn * knp[nt - 1 - i] - 0.05f;
#pragma unroll
            for (int o = 1; o < 64; o <<= 1) s = fminf(s, __shfl_xor(s, o));
            if (lane == 0) wsm[wid] = s; }
    }
};
template <bool PRE = false, class Pol>
__device__ __forceinline__ void run_branch_fox(const Ctx& c, Pol& pol, const bf16* Kg, const bf16* Vg, int pitch, const bf16x8 (&qr)[4], State& st) {
    const int NT = pol.nt; int NTe = NT;
    LAS float* wsf = (LAS float*)(c.shm + L_WS) + c.wid * 64;
    if (!PRE) issue_first(c, pol, Kg, Vg, pitch);
    FA_BAR();
    f32x16 a0, a1, b0, b1;
    pol.init(a0, a1, st.m, 0); qk_tile(c, 0, qr, a0, a1);
    FA_BAR();
    int t = 0;
    for (;; t += 2) {
        if (t >= 2 && t < NTe) {
            float smin = pol.wsm[0];
#pragma unroll
            for (int w = 1; w < NWAVES; ++w) smin = fminf(smin, pol.wsm[w]);
            const float lim = smin - FOX_MARGIN; const int T0 = NT - 1 - t;
            int first = 3;
            if (T0 >= 2 && -pol.ckl[64 * (T0 - 2) + 63] < lim) first = 2;
            if (T0 >= 1 && -pol.ckl[64 * (T0 - 1) + 63] < lim) first = 1;
            if (-pol.ckl[64 * T0 + 63] < lim) first = 0;
            first = __builtin_amdgcn_readfirstlane(first);
            if (first < 3 && t + first < NTe) NTe = t + first;
        }
        if (!(t + 2 < NTe)) break;
        dma_k(c, Kg, pitch, pol.k0(t + 2), 0); dma_v(c, Vg, pitch, pol.k0(t + 1), 1);
        fa_step<true, true>(c, pol, qr, st, a0, a1, b0, b1, t, 0, wsf);
        FA_BAR();
        if (t + 3 < NTe) dma_k(c, Kg, pitch, pol.k0(t + 3), 1);
        dma_v(c, Vg, pitch, pol.k0(t + 2), 0);
        fa_step<true, true>(c, pol, qr, st, b0, b1, a0, a1, t + 1, 1, wsf);
        FA_BAR();
    }
    if (t + 1 < NTe) {
        dma_v(c, Vg, pitch, pol.k0(t + 1), 1);
        fa_step<true, true>(c, pol, qr, st, a0, a1, b0, b1, t, 0, wsf);
        FA_BAR();
        fa_step<false, true>(c, pol, qr, st, b0, b1, a0, a1, t + 1, 1, wsf);
        FA_BAR();
    } else if (t < NTe) {
        fa_step<false, true>(c, pol, qr, st, a0, a1, b0, b1, t, 0, wsf);
        FA_BAR();
    }
}
__device__ __forceinline__ void fox_unit(Frame& F, int b, int h, int qb) {
    Ctx c; { int l_ = F.lane; asm volatile("" : "+v"(l_)); c.lane = l_; } c.r32 = c.lane & 31; c.hi = c.lane >> 5; c.wid = F.wave; c.shm = F.lds + RING_OFF;
    const bf16* P = (const bf16*)(F.ws + WS_P); const float* CK = (const float*)(F.ws + WS_CK) + (size_t)(b * 16 + h) * 4096; bf16* O = (bf16*)(F.ws + WS_O);
    const float* KNT = (const float*)(F.ws + WS_KNT) + (b * 16 + h) * 64;
    const int q0 = qb * 256; const size_t rowbase = (size_t)b * 4096;
    LAS float* ckl = (LAS float*)(c.shm + L_CK); LAS float* knp = (LAS float*)(c.shm + L_KNP); LAS float* wsm = (LAS float*)(c.shm + L_WSM);
    const int tid = c.wid * 64 + c.lane;
    FoxPol pol; pol.nt = (q0 + 256) / 64;
    issue_first(c, pol, P + rowbase * N1 + C_FK + h * 64, P + rowbase * N1 + C_FV + h * 64, N1);
    dma_copy(c, CK, L_CK, qb + 1);
    if (tid < 64) { float v = KNT[tid];
#pragma unroll
        for (int o = 1; o < 64; o <<= 1) { const float u = __shfl_up(v, o); if (c.lane >= o) v = fmaxf(v, u); }
        knp[tid] = v; }
    const int qpos = q0 + c.wid * 32 + c.r32;
    bf16x8 qr[4]; load_q(qr, P + (rowbase + qpos) * N1 + C_FQ + h * 64, c.hi);
    float ss = 0.f;
#pragma unroll
    for (int d0 = 0; d0 < 4; ++d0)
#pragma unroll
        for (int e = 0; e < 8; ++e) { const float v = bf2f((bf16)qr[d0][e]); ss += v * v; }
    { auto rr = __builtin_amdgcn_permlane32_swap(__float_as_uint(ss), __float_as_uint(ss), false, false); ss = __uint_as_float(rr[0]) + __uint_as_float(rr[1]); }
    pol.qpos = qpos; pol.hi = c.hi; pol.lane = c.lane; pol.wid = c.wid; pol.cq = CK[qpos]; pol.qn = sqrtf(ss) * 1.001f; pol.ckl = ckl; pol.knp = knp; pol.wsm = wsm;
    State st; reset(st);
    __syncthreads();
    run_branch_fox<true>(c, pol, P + rowbase * N1 + C_FK + h * 64, P + rowbase * N1 + C_FV + h * 64, N1, qr, st);
    float rl[16]; row_to_regs(c, 1.0f / total_l(st.l), rl);
#pragma unroll
    for (int r = 0; r < 16; ++r) { st.o[0][r] *= rl[r]; st.o[1][r] *= rl[r]; }
    store_o(c, st.o, O + (rowbase + q0 + c.wid * 32) * 1024 + h * 64);
    __syncthreads();
}
__device__ __forceinline__ void ph_fox_flash(Frame& F) {
    if (F.wave >= 4) __builtin_amdgcn_s_setprio(1);
    unsigned* ctr = (unsigned*)(F.ctl + CW_QFOX); LAS int* nxt = (LAS int*)(F.lds + RING_OFF + L_WSM + 64);
#pragma unroll 1
    for (;;) {
        if (F.tid == 0) *nxt = (int)__hip_atomic_fetch_add(ctr, 1u, __ATOMIC_RELAXED, __HIP_MEMORY_SCOPE_AGENT);
        __syncthreads();
        const int u = __builtin_amdgcn_readfirstlane(*nxt);
        if (u >= 2048) break;
        const int bh = u & 127; fox_unit(F, bh >> 4, bh & 15, 15 - (u >> 7));
    }
    __builtin_amdgcn_s_setprio(0);
}
__device__ __forceinline__ void ph_fox_knorm(Frame& F) {
    const bf16* P = (const bf16*)(F.ws + WS_P); float* KNT = (float*)(F.ws + WS_KNT);
    const int kw = (F.G > 128) ? (F.vcu - 128) * NWAVES + F.wave : F.gw, NKW = (F.G > 128) ? (F.G - 128) * NWAVES : F.NGW;
    if (kw < 0) return;
    for (int it = kw; it < 128 * 64; it += NKW) { const int T = it & 63, bh = it >> 6, b = bh >> 4, h = bh & 15;
        const bf16* kp = P + ((size_t)b * 4096 + T * 64 + (F.lane >> 3)) * N1 + C_FK + h * 64 + (F.lane & 7) * 8; float mx = 0.f;
#pragma unroll
        for (int j = 0; j < 8; ++j) { const v4u w = *(const v4u*)(kp + (size_t)(8 * j) * N1);
            float ss = bflo(w.x) * bflo(w.x) + bfhi(w.x) * bfhi(w.x) + bflo(w.y) * bflo(w.y) + bfhi(w.y) * bfhi(w.y) + bflo(w.z) * bflo(w.z) + bfhi(w.z) * bfhi(w.z) + bflo(w.w) * bflo(w.w) + bfhi(w.w) * bfhi(w.w);
            ss += __shfl_xor(ss, 1); ss += __shfl_xor(ss, 2); ss += __shfl_xor(ss, 4); mx = fmaxf(mx, ss); }
        mx = wave_max(mx); if (F.lane == 0) KNT[it] = sqrtf(mx) * 1.0001f; }
}
__device__ __forceinline__ void stage_table(const Frame& F, LAS float* rt, const float* tbh) {
    for (int j = F.tid; j < TB_STRIDE; j += NWAVES * 64) rt[j] = (j < 1024) ? tbh[1023 - j] : 0.f;
}
__device__ __forceinline__ void init_table(f32x16& c0, f32x16& c1, float base, LAS const float* p) {
#pragma unroll
    for (int r = 0; r < 16; ++r) { const int ko = (r & 3) + 8 * (r >> 2); c0[r] = base + p[ko]; c1[r] = base + p[32 + ko]; }
}
__device__ __forceinline__ void init_const(f32x16& c0, f32x16& c1, float v) {
#pragma unroll
    for (int r = 0; r < 16; ++r) { c0[r] = v; c1[r] = v; }
}
__device__ __forceinline__ void mask_causal(f32x16& c0, f32x16& c1, int kb  , int qpos) {
#pragma unroll
    for (int r = 0; r < 16; ++r) { const int kv = kb + (r & 3) + 8 * (r >> 2); if (kv > qpos) c0[r] = MASKV; if (kv + 32 > qpos) c1[r] = MASKV; }
}
struct MobaPol {
    static constexpr bool TRACK = false;
    static constexpr bool LOWREG = false;
    int nt, blk, qpos, q0w, hi; unsigned msel; LAS const float* rt; float c31;
    __device__ __forceinline__ int k0(int i) const { return 64 * i; }
    __device__ __forceinline__ void init(f32x16& c0, f32x16& c1, float m, int i) const {
        const int n = i >> 2; const bool sel = (n == blk) || ((msel >> n) & 1u); const float base = sel ? -m : MASKV;
        if (q0w - 64 * i - 63 < 790) init_table(c0, c1, base, rt + (1023 - qpos + 64 * i + 4 * hi));
        else init_const(c0, c1, base + c31);
    }
    __device__ __forceinline__ void mask(f32x16& c0, f32x16& c1, int i) const { if (i >= nt - 4) mask_causal(c0, c1, 64 * i + 4 * hi, qpos); }
};
__device__ __forceinline__ void moba_unit(Frame& F, int b, int h, int blk) {
    Ctx c; { int l_ = F.lane; asm volatile("" : "+v"(l_)); c.lane = l_; } c.r32 = c.lane & 31; c.hi = c.lane >> 5; c.wid = F.wave; c.shm = F.lds + RING_OFF;
    const bf16* P = (const bf16*)(F.ws + WS_P); const float* TB = (const float*)(F.ws + WS_TB) + h * 1024; bf16* O = (bf16*)(F.ws + WS_O);
    const int q0 = blk * 256; const size_t rowbase = (size_t)b * 4096;
    LAS float* rt = (LAS float*)(c.shm + L_TB);
    MobaPol pol; pol.nt = 4 * (blk + 1);
    issue_first(c, pol, P + rowbase * N0 + C_MK + h * 64, P + rowbase * N0 + C_MV + h * 64, N0);
    dma_copy(c, (const float*)(F.ws + WS_RT) + h * TB_STRIDE, L_TB, 5);
    const int qpos = q0 + c.wid * 32 + c.r32;
    bf16x8 qr[4]; load_q(qr, P + (rowbase + qpos) * N0 + C_MQ + h * 64, c.hi);
    unsigned msel = 0u;
    if (blk > 0) {
        const float* KM = (const float*)(F.ws + WS_KMEAN) + (size_t)((b * 8 + h) * 16) * 64;
        f32x16 rs = {};
#pragma unroll
        for (int d0 = 0; d0 < 4; ++d0) { bf16x8 ah = {}, al = {};
            if (c.r32 < 16) { const float* kp = KM + c.r32 * 64 + d0 * 16 + c.hi * 8; const f32x4 x0 = *(const f32x4*)kp, x1 = *(const f32x4*)(kp + 4);
#pragma unroll
                for (int e = 0; e < 4; ++e) { const unsigned h0 = f2bf(x0[e]), h1 = f2bf(x1[e]); ah[e] = (short)h0; ah[4 + e] = (short)h1;
                    al[e] = (short)f2bf(x0[e] - bf2f((bf16)h0)); al[4 + e] = (short)f2bf(x1[e] - bf2f((bf16)h1)); } }
            rs = __builtin_amdgcn_mfma_f32_32x32x16_bf16(ah, qr[d0], rs, 0, 0, 0); rs = __builtin_amdgcn_mfma_f32_32x32x16_bf16(al, qr[d0], rs, 0, 0, 0); }
        float own[8], oth[8];
#pragma unroll
        for (int i = 0; i < 8; ++i) { own[i] = rs[i]; auto rr = __builtin_amdgcn_permlane32_swap(__float_as_uint(own[i]), __float_as_uint(own[i]), false, false); oth[i] = __uint_as_float(c.hi ? rr[0] : rr[1]); }
#pragma unroll
        for (int r = 0; r < 3; ++r) { float best = -3.0e38f; int bi = 99;
#pragma unroll
            for (int i = 0; i < 8; ++i) { const int no = (i & 3) + 8 * (i >> 2) + 4 * c.hi, np = (i & 3) + 8 * (i >> 2) + 4 * (1 - c.hi);
                if (no < blk && !((msel >> no) & 1u) && (own[i] > best || (own[i] == best && no < bi))) { best = own[i]; bi = no; }
                if (np < blk && !((msel >> np) & 1u) && (oth[i] > best || (oth[i] == best && np < bi))) { best = oth[i]; bi = np; } }
            if (bi < 16) msel |= 1u << bi; }
    }
    pol.blk = blk; pol.qpos = qpos; pol.q0w = q0 + c.wid * 32; pol.hi = c.hi; pol.msel = msel; pol.rt = rt; pol.c31 = TB[1023];
    State st; reset(st);
    __syncthreads();
    run_branch<true>(c, pol, P + rowbase * N0 + C_MK + h * 64, P + rowbase * N0 + C_MV + h * 64, N0, qr, st);
    float rl[16]; row_to_regs(c, 1.0f / total_l(st.l), rl);
#pragma unroll
    for (int r = 0; r < 16; ++r) { st.o[0][r] *= rl[r]; st.o[1][r] *= rl[r]; }
    store_o(c, st.o, O + (rowbase + q0 + c.wid * 32) * 1024 + h * 64);
    __syncthreads();
}
__device__ __forceinline__ void ph_moba_flash(Frame& F) {
    if (F.wave >= 4) __builtin_amdgcn_s_setprio(1);
    unsigned* ctr = (unsigned*)(F.ctl + CW_QMOBA); LAS int* nxt = (LAS int*)(F.lds + RING_OFF + L_WS + NWAVES * 64 * 4 - 16);
#pragma unroll 1
    for (;;) {
        if (F.tid == 0) *nxt = (int)__hip_atomic_fetch_add(ctr, 1u, __ATOMIC_RELAXED, __HIP_MEMORY_SCOPE_AGENT);
        __syncthreads();
        const int u = __builtin_amdgcn_readfirstlane(*nxt);
        if (u >= 1024 + LATE_CHUNKS) break;
        int mu = u - LATE_CHUNKS;
        if (u < 6 * LATE_CHUNKS) { if (u % 6 == 5) { late_weight_chunk(F, u / 6); __syncthreads(); continue; } mu = u - u / 6; }
        const int bh = mu & 63; moba_unit(F, bh >> 3, bh & 7, 15 - (mu >> 6));
    }
    __builtin_amdgcn_s_setprio(0);
}
__device__ __forceinline__ void cmp2_tile(Frame& F, int pm) {
    asm volatile("s_waitcnt vmcnt(0)" ::: "memory"); __syncthreads();
    const int lane = F.lane, r32 = lane & 31, hi = lane >> 5, w8 = F.wave, w = pm >> 4;
    const bf16* A = (const bf16*)(F.ws + WS_HID) + (size_t)(pm * 256 + 32 * w8 + r32) * 256 + hi * 8;
#pragma unroll
    for (int cb = 0; cb < 2; ++cb) {
        const bf16* W2 = (const bf16*)(F.ws + WS_W2T) + (size_t)(w * 64 + 32 * cb + r32) * 256 + hi * 8; f32x16 o = {};
#pragma unroll
        for (int ks = 0; ks < 16; ++ks) { const bf16x8 av = *(const bf16x8*)(A + ks * 16), bv = *(const bf16x8*)(W2 + ks * 16); o = __builtin_amdgcn_mfma_f32_32x32x16_bf16(av, bv, o, 0, 0, 0); }
        bf16* KV = (bf16*)(F.ws + WS_KVCMP) + ((size_t)pm * 256 + 32 * w8) * 64 + 32 * cb + r32;
#pragma unroll
        for (int r = 0; r < 16; ++r) KV[(size_t)((r & 3) + 8 * (r >> 2) + 4 * hi) * 64] = (bf16)f2bf(o[r]);
    }
}
struct SlcPol {
    static constexpr bool TRACK = false;
    static constexpr bool LOWREG = true;
    int nt, qpos, q0w, hi; unsigned long long ssel; LAS const float* rt; float c31;
    __device__ __forceinline__ int k0(int i) const { return 64 * i; }
    __device__ __forceinline__ void init(f32x16& c0, f32x16& c1, float m, int i) const {
        const bool sel = (ssel >> i) & 1ull; const float base = sel ? -m : MASKV;
        if (q0w - 64 * i - 63 < 790) init_table(c0, c1, base, rt + (1023 - qpos + 64 * i + 4 * hi));
        else init_const(c0, c1, base + c31);
    }
    __device__ __forceinline__ void mask(f32x16& c0, f32x16& c1, int i) const { if (i == nt - 1) mask_causal(c0, c1, 64 * i + 4 * hi, qpos); }
};
struct WinPol {
    static constexpr bool TRACK = false;
    static constexpr bool LOWREG = true;
    int nt, t0, sb, qpos, hi; LAS const float* rt;
    __device__ __forceinline__ int k0(int i) const { return 64 * (t0 + i); }
    __device__ __forceinline__ void init(f32x16& c0, f32x16& c1, float m, int i) const { init_table(c0, c1, -m, rt + (1023 - qpos + 64 * (t0 + i) + 4 * hi)); }
    __device__ __forceinline__ void mask(f32x16& c0, f32x16& c1, int i) const {
        const int tb = t0 + i, kb = 64 * tb + 4 * hi;
        if (tb == sb) mask_causal(c0, c1, kb, qpos);
        if (tb == sb - 8) {
#pragma unroll
            for (int r = 0; r < 16; ++r) { const int kv = kb + (r & 3) + 8 * (r >> 2); if (qpos - kv > 511) c0[r] = MASKV; if (qpos - kv - 32 > 511) c1[r] = MASKV; } }
    }
};
struct CmpPol {
    static constexpr bool TRACK = false;
    static constexpr bool LOWREG = true;
    int nt, qpos, hi; LAS const float* rt;
    __device__ __forceinline__ int k0(int i) const { return 64 * i; }
    __device__ __forceinline__ void init(f32x16& c0, f32x16& c1, float m, int i) const {
        const int ib = 1054 - qpos + 16 * (64 * i + 4 * hi);
#pragma unroll
        for (int r = 0; r < 16; ++r) { const int ko = 16 * ((r & 3) + 8 * (r >> 2)); const int i0 = ib + ko, i1 = ib + ko + 512;
            c0[r] = rt[i0 > 0 ? i0 : 0] - m; c1[r] = rt[i1 > 0 ? i1 : 0] - m; if ((r & 3) == 3) asm volatile("" ::: "memory"); }
    }
    __device__ __forceinline__ void mask(f32x16& c0, f32x16& c1, int i) const {
        const int nb = 64 * i + 4 * hi;
#pragma unroll
        for (int r = 0; r < 16; ++r) { const int n = nb + (r & 3) + 8 * (r >> 2); if (16 * n + 31 > qpos) c0[r] = MASKV; if (16 * (n + 32) + 31 > qpos) c1[r] = MASKV; }
    }
};
__device__ __forceinline__ void nsa_unit(Frame& F, int b, int g, int qblk) {
    Ctx c; { int l_ = F.lane; asm volatile("" : "+v"(l_)); c.lane = l_; } c.r32 = c.lane & 31; c.hi = c.lane >> 5; c.wid = F.wave; c.shm = F.lds + RING_OFF;
    const bf16* P = (const bf16*)(F.ws + WS_P); const float* TB = (const float*)(F.ws + WS_TB); bf16* O = (bf16*)(F.ws + WS_O);
    const bf16* KVC = (const bf16*)(F.ws + WS_KVCMP); const float* GZ = (const float*)(F.ws + WS_GZ);
    const int q0 = qblk * 64, sb = qblk; const size_t rowbase = (size_t)b * 4096;
    const int j = c.wid >> 1, sub = c.wid & 1, hn = 4 * g + j;
    const bf16* Kc = KVC + (size_t)((0 * 16 + b * 2 + g) * 256) * 64; const bf16* Vc = KVC + (size_t)((1 * 16 + b * 2 + g) * 256) * 64;
    CmpPol cpol; cpol.nt = (4 * qblk + 3 + 63) >> 6;
    issue_first(c, cpol, Kc, Vc, 64);
    dma_copy(c, (const float*)(F.ws + WS_RT) + (8 + 4 * g) * TB_STRIDE, L_TB, 20);
    LAS const float* rt = (LAS const float*)(c.shm + L_TB) + j * TB_STRIDE;
    LAS unsigned* impfx = (LAS unsigned*)(c.shm + L_IMP);
    LAS unsigned long long* sel64 = (LAS unsigned long long*)(c.shm + L_SEL);
    for (int i = F.tid; i < 2 * 65 * 32; i += NWAVES * 64) impfx[i] = 0u;
    const int qpos = q0 + sub * 32 + c.r32; const size_t row = rowbase + qpos;
    bf16x8 qr[4]; load_q(qr, P + row * N0 + C_NQ + hn * 64, c.hi);
    const float g0 = 1.f / (1.f + __expf(-GZ[row * 32 + hn * 3 + 0])), g1 = 1.f / (1.f + __expf(-GZ[row * 32 + hn * 3 + 1])), g2 = 1.f / (1.f + __expf(-GZ[row * 32 + hn * 3 + 2]));
    LAS float* park = (LAS float*)(c.shm + L_OST + c.wid * 8192);
    State st; reset(st);
    __syncthreads();
    {   CmpPol& pol = cpol; pol.qpos = qpos; pol.hi = c.hi; pol.rt = rt;
        run_branch<true>(c, pol, Kc, Vc, 64, qr, st);
        const float lt = total_l(st.l); const float inv = (lt > 0.f) ? 1.0f / lt : 0.f;
        { float rl[16]; row_to_regs(c, g0 * inv, rl);
#pragma unroll
          for (int r = 0; r < 16; ++r) { park[r * 128 + c.lane] = st.o[0][r] * rl[r]; park[r * 128 + 64 + c.lane] = st.o[1][r] * rl[r]; } }
        const float sc = inv * 16777216.0f;
        dma_kv(c, Kc, Vc, 64, 0, 0); FA_BAR();
        for (int i = 0; i < pol.nt; ++i) { const int slot = i & 1;
            if (i + 1 < pol.nt) dma_kv(c, Kc, Vc, 64, 64 * (i + 1), slot ^ 1);
            f32x16 c0, c1; pol.init(c0, c1, st.m, i);
            qk_tile(c, slot, qr, c0, c1);
            pol.mask(c0, c1, i);
            LAS unsigned* ib = impfx + (sub * 65 + 16 * i + c.hi) * 32 + c.r32;
#pragma unroll
            for (int gq = 0; gq < 4; ++gq) {
                const float a0 = __builtin_amdgcn_exp2f(c0[4 * gq]) * sc, a1 = __builtin_amdgcn_exp2f(c0[4 * gq + 1]) * sc, a2 = __builtin_amdgcn_exp2f(c0[4 * gq + 2]) * sc, a3 = __builtin_amdgcn_exp2f(c0[4 * gq + 3]) * sc;
                const float b0 = __builtin_amdgcn_exp2f(c1[4 * gq]) * sc, b1 = __builtin_amdgcn_exp2f(c1[4 * gq + 1]) * sc, b2 = __builtin_amdgcn_exp2f(c1[4 * gq + 2]) * sc, b3 = __builtin_amdgcn_exp2f(c1[4 * gq + 3]) * sc;
                const unsigned ua3 = (unsigned)(a3 + 0.5f), ub3 = (unsigned)(b3 + 0.5f);
                const unsigned ua = (unsigned)(a0 + 0.5f) + (unsigned)(a1 + 0.5f) + (unsigned)(a2 + 0.5f) + ua3, ub = (unsigned)(b0 + 0.5f) + (unsigned)(b1 + 0.5f) + (unsigned)(b2 + 0.5f) + ub3;
                __hip_atomic_fetch_add(ib + (2 * gq) * 32, ua, __ATOMIC_RELAXED, __HIP_MEMORY_SCOPE_WORKGROUP); __hip_atomic_fetch_add(ib + (2 * gq + 1) * 32, ua3, __ATOMIC_RELAXED, __HIP_MEMORY_SCOPE_WORKGROUP);
                __hip_atomic_fetch_add(ib + (8 + 2 * gq) * 32, ub, __ATOMIC_RELAXED, __HIP_MEMORY_SCOPE_WORKGROUP); __hip_atomic_fetch_add(ib + (8 + 2 * gq + 1) * 32, ub3, __ATOMIC_RELAXED, __HIP_MEMORY_SCOPE_WORKGROUP);
            }
            FA_BAR();
        }
    }
    SlcPol spol; spol.nt = sb + 1;
    issue_first(c, spol, P + rowbase * N0 + C_KSL + g * 64, P + rowbase * N0 + C_VSL + g * 64, N0);
    for (int k = 0; k < 8; ++k) { const int qq = c.wid * 8 + k; const int m = c.lane;
        const unsigned v = impfx[((qq >> 5) * 65 + m) * 32 + (qq & 31)];
        const bool valid = m <= sb, forced = (m == 0) || (m == sb) || (m == sb - 1);
        const unsigned key = (valid && !forced) ? v + 1u : 0u;
        const int nforced = (sb >= 2) ? 3 : sb + 1; const int R = 16 - nforced;
        bool pick = key > 0u;
        if (__popcll(__ballot(key > 0u)) > R) {
            unsigned T = 0u;
#pragma unroll 1
            for (int bit = 27; bit >= 0; --bit) { const unsigned cand = T | (1u << bit); if (__popcll(__ballot(key >= cand)) >= R) T = cand; }
            const int G = __popcll(__ballot(key > T)); const unsigned long long E = __ballot(key == T);
            const int before = __popcll(E & ((1ull << m) - 1ull));
            pick = (key > T) || (key == T && before < R - G);
        }
        const unsigned long long msk = __ballot(valid && (forced || pick));
        if (c.lane == 0) sel64[qq] = msk; }
    LDS_WAIT();
    __syncthreads();
    reset(st);
    { SlcPol& pol = spol; pol.qpos = qpos; pol.q0w = q0 + sub * 32; pol.hi = c.hi; pol.ssel = sel64[sub * 32 + c.r32]; pol.rt = rt; pol.c31 = TB[(8 + hn) * 1024 + 1023];
      run_branch<true>(c, pol, P + rowbase * N0 + C_KSL + g * 64, P + rowbase * N0 + C_VSL + g * 64, N0, qr, st); }
    WinPol wpol; wpol.t0 = (sb >= 8) ? sb - 8 : 0; wpol.nt = sb - wpol.t0 + 1;
    issue_first(c, wpol, P + rowbase * N0 + C_KWN + g * 64, P + rowbase * N0 + C_VWN + g * 64, N0);
    { float rl[16]; row_to_regs(c, g1 / total_l(st.l), rl);
#pragma unroll
      for (int r = 0; r < 16; ++r) { park[r * 128 + c.lane] += st.o[0][r] * rl[r]; park[r * 128 + 64 + c.lane] += st.o[1][r] * rl[r]; } }
    reset(st);
    { WinPol& pol = wpol; pol.sb = sb; pol.qpos = qpos; pol.hi = c.hi; pol.rt = rt;
      run_branch<true>(c, pol, P + rowbase * N0 + C_KWN + g * 64, P + rowbase * N0 + C_VWN + g * 64, N0, qr, st); }
    { float rl[16]; row_to_regs(c, g2 / total_l(st.l), rl);
#pragma unroll
      for (int r = 0; r < 16; ++r) { st.o[0][r] = st.o[0][r] * rl[r] + park[r * 128 + c.lane]; st.o[1][r] = st.o[1][r] * rl[r] + park[r * 128 + 64 + c.lane]; } }
    LDS_WAIT();
    store_o(c, st.o, O + (rowbase + q0 + sub * 32) * 1024 + (8 + hn) * 64);
    __syncthreads();
}
__device__ __forceinline__ void ph_nsa_flash(Frame& F) {
    if (F.wave >= 4) __builtin_amdgcn_s_setprio(1);
    unsigned* ctr = (unsigned*)(F.ctl + CW_QNSA); LAS int* nxt = (LAS int*)(F.lds + RING_OFF + L_WS + NWAVES * 64 * 4 - 16);
#pragma unroll 1
    for (;;) {
        if (F.tid == 0) *nxt = (int)__hip_atomic_fetch_add(ctr, 1u, __ATOMIC_RELAXED, __HIP_MEMORY_SCOPE_AGENT);
        __syncthreads();
        const int u = __builtin_amdgcn_readfirstlane(*nxt);
        if (u >= 1024) break;
        const int bg = u & 15; nsa_unit(F, bg >> 1, bg & 1, 63 - (u >> 4));
    }
    __builtin_amdgcn_s_setprio(0);
}
}
constexpr int N_PHASES = 16;
__global__ void __launch_bounds__(NWAVES * 64, 2) trunk_fwd(Args args) {
    extern __shared__ __attribute__((aligned(16))) unsigned char lds[];
    Frame F;
    F.lds = (LAS unsigned char*)lds;
    F.MISC = (volatile LAS unsigned*)(F.lds + MISC_OFF);
    F.tid = threadIdx.x; F.lane = F.tid & 63; F.wave = __builtin_amdgcn_readfirstlane(F.tid >> 6);
    F.G = gridDim.x; { const int bx = blockIdx.x; F.vcu = (F.G % 8 == 0) ? (bx % 8) * (F.G / 8) + bx / 8 : bx; }
    F.gw = F.vcu * NWAVES + F.wave; F.NGW = F.G * NWAVES;
    unsigned char* ws = args.ws; F.ws = ws;
    F.ctl = (gu32*)(ws + WS_CTL);
    for (int u = F.tid; u < (LDS_BYTES - LDSCTL_OFF) / 4; u += NWAVES * 64) ((LAS unsigned*)(F.lds + LDSCTL_OFF))[u] = 0u;
    __syncthreads();
    XcdBarrier bar = xcd_barrier_post((unsigned*)(F.ctl + CW_BAR), F.MISC + 8);
    const int lo = args.ph_lo, hi = args.ph_hi;
#define IN(k) (lo <= (k) && (k) < hi)
#define SEAM(k) do { if (IN(k) && IN((k) + 1)) xcd_barrier(bar); { int t_ = threadIdx.x; asm volatile("" : "+v"(t_)); F.tid = t_; F.lane = t_ & 63; } } while (0)
    float* SSQ = (float*)(ws + WS_SSQ);
    LAS float* RSTAB = (LAS float*)(F.lds + LDSCTL_OFF + 1024);
    bf16* XB = (bf16*)(ws + WS_XB); bf16* XL = (bf16*)(ws + WS_XL); bf16* P = (bf16*)(ws + WS_P); bf16* O = (bf16*)(ws + WS_O); bf16* A = (bf16*)(ws + WS_A);

    if (IN(0)) { p0_prologue(F, args); }
    SEAM(0);
    if (IN(1)) {
        pg8::Gemm g{XB, (const bf16*)(ws + WS_WIN0), M, N0G, 1024, 1024}; pg8::StaticOrder S; S.init(M, N0G, F.G, (int)blockIdx.x);
        pg8::EpiProj E{P, N0, SSQ, C2, (1u << 0) | (1u << 1) | (1u << 6) | (1u << 7), 8, (bf16*)(ws + WS_CMPIN), 11, (float*)(ws + WS_GZ), (float*)(ws + WS_KMEAN)};
        pg8::gemm_phase<pg8::EpiProj, pg8::StaticOrder, true, true>(F.lds + RING_OFF, g, S, E, SSQ, RSTAB);
    }
    SEAM(1);
    if (IN(2)) {
        if (F.vcu < 32) {
            pg8::Gemm g{(const bf16*)(ws + WS_CMPIN), (const bf16*)(ws + WS_WCMP), 8192, 512, 2048, 1024}; pg8::CmpOrder S{F.G, F.vcu};
            pg8::EpiSilu E{(bf16*)(ws + WS_HID), (const float*)(ws + WS_POSB)};
            pg8::gemm_phase<pg8::EpiSilu, pg8::CmpOrder, false, true>(F.lds + RING_OFF, g, S, E);
            fa::cmp2_tile(F, F.vcu);
            asm volatile("s_waitcnt vmcnt(0)" ::: "memory"); __syncthreads();
            if (F.tid == 0) { __builtin_amdgcn_fence(__ATOMIC_RELEASE, "agent"); asm volatile("s_waitcnt vmcnt(0)" ::: "memory");
                __hip_atomic_fetch_add((unsigned*)(F.ctl + CW_CMPDONE), 1u, __ATOMIC_RELAXED, __HIP_MEMORY_SCOPE_AGENT); }
            __syncthreads();
        }
        fa::ph_moba_flash(F);
    }
    if (IN(5)) {
        if (F.tid == 0) { unsigned sp = 0; const int want = (F.G >= 32) ? 32 : F.G;
            while ((int)__hip_atomic_load((unsigned*)(F.ctl + CW_CMPDONE), __ATOMIC_RELAXED, __HIP_MEMORY_SCOPE_AGENT) < want) { __builtin_amdgcn_s_sleep(2); if (++sp > (1u << 22)) break; }
            __builtin_amdgcn_fence(__ATOMIC_ACQUIRE, "agent"); asm volatile("s_waitcnt vmcnt(0)" ::: "memory"); }
        __syncthreads();
        fa::ph_nsa_flash(F);
    }
    SEAM(5);
    if (IN(6)) {
        pg8::Gemm g{O, (const bf16*)(ws + WS_WOUT0), M, 1024, 1024, 1024}; pg8::StaticOrder S; S.init(M, 1024, F.G, (int)blockIdx.x);
        pg8::EpiRes0 E{KIN(I_X), nullptr, XB, XL, SSQ + M};
        pg8::gemm_phase<pg8::EpiRes0, pg8::StaticOrder, true, true>(F.lds + RING_OFF, g, S, E);
    }
    SEAM(6);
    if (IN(7)) {
        pg8::Gemm g{XB, (const bf16*)(ws + WS_W1_0), M, FF, 1024, 1024}; pg8::StaticOrder S; S.init(M, FF, F.G, (int)blockIdx.x);
        pg8::EpiUp E{A, FF, SSQ + M};
        pg8::gemm_phase<pg8::EpiUp, pg8::StaticOrder, true, true>(F.lds + RING_OFF, g, S, E, SSQ + M, RSTAB);
    }
    SEAM(7);
    if (IN(8)) {
        pg8::Gemm g{A, (const bf16*)(ws + WS_W2_0), M, 1024, FF, FF}; pg8::StaticOrder S; S.init(M, 1024, F.G, (int)blockIdx.x);
        pg8::EpiRes1 E{nullptr, nullptr, XB, XL, SSQ + 2 * M};
        pg8::gemm_phase<pg8::EpiRes1, pg8::StaticOrder, true, true>(F.lds + RING_OFF, g, S, E);
    }
    SEAM(8);
    if (IN(9)) {
        pg8::Gemm g{XB, (const bf16*)(ws + WS_WIN1), M, N1, 1024, 1024}; pg8::StaticOrder S; S.init(M, N1, F.G, (int)blockIdx.x);
        pg8::EpiProj E{P, N1, SSQ + 2 * M, C2, 0xFu, 1000, (bf16*)(ws + WS_CMPIN), 1000, (float*)(ws + WS_GZ), nullptr};
        pg8::gemm_phase<pg8::EpiProj, pg8::StaticOrder, true, true>(F.lds + RING_OFF, g, S, E, SSQ + 2 * M, RSTAB);
        skinny_gemm(F, XB, (const bf16*)(ws + WS_WF1), SSQ + 2 * M, (float*)(ws + WS_GZ));
    }
    SEAM(9);
    if (IN(10)) { ph_fox_cum(F, args); fa::ph_fox_knorm(F); }
    SEAM(10);
    if (IN(11)) { fa::ph_fox_flash(F); }
    SEAM(11);
    if (IN(12)) {
        pg8::Gemm g{O, (const bf16*)(ws + WS_WOUT1), M, 1024, 1024, 1024}; pg8::StaticOrder S; S.init(M, 1024, F.G, (int)blockIdx.x);
        pg8::EpiRes1 E{nullptr, nullptr, XB, XL, SSQ + 3 * M};
        pg8::gemm_phase<pg8::EpiRes1, pg8::StaticOrder, true, true>(F.lds + RING_OFF, g, S, E);
    }
    SEAM(12);
    if (IN(13)) {
        pg8::Gemm g{XB, (const bf16*)(ws + WS_W1_1), M, FF, 1024, 1024}; pg8::StaticOrder S; S.init(M, FF, F.G, (int)blockIdx.x);
        pg8::EpiUp E{A, FF, SSQ + 3 * M};
        pg8::gemm_phase<pg8::EpiUp, pg8::StaticOrder, true, true>(F.lds + RING_OFF, g, S, E, SSQ + 3 * M, RSTAB);
    }
    SEAM(13);
    if (IN(14)) {
        pg8::Gemm g{A, (const bf16*)(ws + WS_W2_1), M, 1024, FF, FF}; pg8::StaticOrder S; S.init(M, 1024, F.G, (int)blockIdx.x);
        pg8::EpiRes2 E{nullptr, KOUT(), XB, XL, SSQ};
        pg8::gemm_phase<pg8::EpiRes2, pg8::StaticOrder, true, true>(F.lds + RING_OFF, g, S, E);
    }
    SEAM(14);
    if (IN(15)) { ph_final_norm(F, args); }
#undef IN
#undef SEAM
}

extern "C" void kernel_launch(void* const* d_in, const int* in_sizes, int n_in, void* d_out, int out_size, void* d_ws, size_t ws_size, hipStream_t stream) {
    static int grid = 0;
    if (grid == 0) {
        if (n_in != 18 || out_size != M * DM || ws_size < WS_END) { fprintf(stderr, "kernel_launch: unexpected shapes: n_in %d out %d ws %zu (need %zu)\n", n_in, out_size, ws_size, (size_t)WS_END); grid = -1; return; }
        int dev = 0, cus = 0, per_cu = 0;
        if (hipGetDevice(&dev) != hipSuccess || hipDeviceGetAttribute(&cus, hipDeviceAttributeMultiprocessorCount, dev) != hipSuccess) { grid = -1; return; }
        if (hipFuncSetAttribute((const void*)trunk_fwd, hipFuncAttributeMaxDynamicSharedMemorySize, LDS_BYTES) != hipSuccess) { fprintf(stderr, "kernel_launch: hipFuncSetAttribute failed\n"); grid = -1; return; }
        if (hipOccupancyMaxActiveBlocksPerMultiprocessor(&per_cu, (const void*)trunk_fwd, NWAVES * 64, LDS_BYTES) != hipSuccess || per_cu < 1) { fprintf(stderr, "kernel_launch: occupancy query says %d\n", per_cu); per_cu = 1; }
        (void)hipGetLastError();
        grid = cus;
    }
    if (grid < 0) return;
    (void)hipMemsetAsync((char*)d_ws + WS_CTL, 0, CTL_ZERO_BYTES, stream);
    Args a{};
    for (int i = 0; i < 18; ++i) a.in[i] = (const float*)d_in[i];
    a.out = (float*)d_out; a.ws = (unsigned char*)d_ws; a.ph_lo = 0; a.ph_hi = N_PHASES;
    hipLaunchKernelGGL(trunk_fwd, dim3(grid), dim3(NWAVES * 64), LDS_BYTES, stream, a);
}
```

```cpp
#include <hip/hip_runtime.h>
#include <cstdio>
#include <cstdint>
namespace pg8 {
#define PG8_LAS __attribute__((address_space(3)))
typedef unsigned short bf16_t;
typedef short bf16x8 __attribute__((ext_vector_type(8)));
typedef float f32x4 __attribute__((ext_vector_type(4)));
typedef unsigned u32x4 __attribute__((ext_vector_type(4)));
typedef unsigned u32x2 __attribute__((ext_vector_type(2)));
constexpr int BM = 256, BK = 64, HALF = 128, HTB = HALF * BK * 2  , STAGE_BYTES = 8 * HTB, NXCD = 8, WGM = 8;

__host__ __device__ __forceinline__ int lds_byte(int r, int c) { const int st = (r >> 4) * 2 + (c >> 5), rr = r & 15, cc = c & 31, ob = rr * 64 + cc * 2; return st * 1024 + (ob ^ (((ob >> 9) & 1) << 5)); }
__host__ __device__ __forceinline__ void stage_rc(int b, int& R, int& C) { const int st = b / 1024, sb = b % 1024, swz = sb ^ (((sb >> 9) & 1) << 5); R = (st >> 1) * 16 + swz / 64; C = (st & 1) * 32 + (swz % 64) / 2; }
__host__ __device__ __forceinline__ int perm32(int rho) { const int n = rho >> 4, i = rho & 15; return 8 * (i >> 2) + 4 * n + (i & 3); }

struct Unit { int pm, pn; };
struct Gemm { const bf16_t* A; const bf16_t* Bt; int M, N, K, lda; };

struct StaticOrder {
    int nM, nN, nwg, G, c;
    __host__ __device__ void init(int M, int N, int G_, int c_) { nM = M / BM; nN = N / BM; nwg = nM * nN; G = G_; c = c_; }
    __host__ __device__ bool next(int i, Unit& u) const {
        const long L = (long)i * G + c; if (L >= nwg) return false;
        int wgid = (int)L; { const int q = nwg / NXCD, r = nwg % NXCD, xcd = wgid % NXCD, off = wgid / NXCD; wgid = (xcd < r ? xcd * (q + 1) : r * (q + 1) + (xcd - r) * q) + off; }
        const int nig = WGM * nN, gid = wgid / nig, fm = gid * WGM, gsz = (nM - fm) < WGM ? (nM - fm) : WGM;
        u.pm = fm + ((wgid % nig) % gsz); u.pn = (wgid % nig) / gsz; return true;
    }
};
struct CmpOrder {
    int G, c;
    __device__ bool next(int i, Unit& u) const { const int L = i * G + c; if (L >= 32) return false; u.pm = L; u.pn = L >> 4; return true; }
};

__device__ __forceinline__ unsigned cvt_pk_bf16(float lo, float hi) { unsigned r; asm volatile("v_cvt_pk_bf16_f32 %0, %1, %2" : "=v"(r) : "v"(lo), "v"(hi)); return r; }

struct EpiProj {
    static constexpr bool PERM = true;
    bf16_t* O; int ldc; const float* ssq; float c2; unsigned qtiles; int cmp_tile; bf16_t* cmpin; int gate_tile; float* gz; float* km;
    __device__ __forceinline__ void operator()(const f32x4 (&acc)[2][2][4][2], const Unit& u, int wr, int wc, int fr, int fq, PG8_LAS const float* rs_tab) const {
        const int row0 = u.pm * BM + wr * 64 + fr; const int colt = u.pn * BM;
        const float sc = ((qtiles >> u.pn) & 1u) ? c2 : 1.f;
        const bool iscmp = (u.pn == cmp_tile);
        if (u.pn == gate_tile) {
            if (wc == 0) {
#pragma unroll
                for (int ai = 0; ai < 2; ++ai)
#pragma unroll
                    for (int m = 0; m < 4; ++m) { const int row = row0 + ai * HALF + m * 16; const float rs = rs_tab[row & 255];
                        *(f32x4*)(gz + (size_t)row * 32 + 8 * fq) = acc[ai][0][m][0] * rs; *(f32x4*)(gz + (size_t)row * 32 + 8 * fq + 4) = acc[ai][0][m][1] * rs; } }
            return;
        }
        const bool iskm = (km != nullptr) && (u.pn == 2 || u.pn == 3);
        float cs[2][2][4];
#pragma unroll
        for (int bj = 0; bj < 2; ++bj)
#pragma unroll
            for (int n = 0; n < 2; ++n)
#pragma unroll
                for (int e = 0; e < 4; ++e) cs[bj][n][e] = 0.f;
#pragma unroll
        for (int ai = 0; ai < 2; ++ai)
#pragma unroll
            for (int m = 0; m < 4; ++m) { const int row = row0 + ai * HALF + m * 16; const float rs = sc * rs_tab[row & 255];
#pragma unroll
                for (int bj = 0; bj < 2; ++bj) { const f32x4 v0 = acc[ai][bj][m][0] * rs, v1 = acc[ai][bj][m][1] * rs;
                    u32x4 w; w.x = cvt_pk_bf16(v0[0], v0[1]); w.y = cvt_pk_bf16(v0[2], v0[3]); w.z = cvt_pk_bf16(v1[0], v1[1]); w.w = cvt_pk_bf16(v1[2], v1[3]);
                    if (iskm) {
#pragma unroll
                        for (int e = 0; e < 4; ++e) { cs[bj][0][e] += v0[e]; cs[bj][1][e] += v1[e]; } }
                    bf16_t* dst;
                    if (iscmp) { const int b = row >> 12, s = row & 4095, g = wc >> 1, d0 = 32 * (wc & 1) + 8 * fq; dst = cmpin + ((size_t)((bj * 16 + b * 2 + g) * 4096 + s)) * 64 + d0; }
                    else dst = O + (size_t)row * ldc + colt + bj * HALF + wc * 32 + 8 * fq;
                    *(u32x4*)dst = w; } }
        if (iskm) {
            const int b = u.pm >> 4, nb = u.pm & 15;
#pragma unroll
            for (int bj = 0; bj < 2; ++bj)
#pragma unroll
                for (int n = 0; n < 2; ++n)
#pragma unroll
                    for (int e = 0; e < 4; ++e) { float s = cs[bj][n][e]; s += __shfl_xor(s, 1); s += __shfl_xor(s, 2); s += __shfl_xor(s, 4); s += __shfl_xor(s, 8);
                        if (fr == 0) { const int c = bj * HALF + wc * 32 + 8 * fq + 4 * n + e; const int h = (u.pn - 2) * 4 + (c >> 6), d = c & 63;
                            atomicAdd(km + ((b * 8 + h) * 16 + nb) * 64 + d, s * (1.0f / 256.0f)); } }
        }
    }
};
struct EpiUp {
    static constexpr bool PERM = true;
    bf16_t* O; int ldc; const float* ssq;
    __device__ __forceinline__ void operator()(const f32x4 (&acc)[2][2][4][2], const Unit& u, int wr, int wc, int fr, int fq, PG8_LAS const float* rs_tab) const {
        const int row0 = u.pm * BM + wr * 64 + fr; const int col0 = u.pn * BM + wc * 32 + 8 * fq;
#pragma unroll
        for (int ai = 0; ai < 2; ++ai)
#pragma unroll
            for (int m = 0; m < 4; ++m) { const int row = row0 + ai * HALF + m * 16; const float rs = rs_tab[row & 255];
#pragma unroll
                for (int bj = 0; bj < 2; ++bj) { f32x4 v0 = acc[ai][bj][m][0] * rs, v1 = acc[ai][bj][m][1] * rs;
#pragma unroll
                    for (int e = 0; e < 4; ++e) { const float a = fmaxf(v0[e], 0.f), b = fmaxf(v1[e], 0.f); v0[e] = a * a; v1[e] = b * b; }
                    u32x4 w; w.x = cvt_pk_bf16(v0[0], v0[1]); w.y = cvt_pk_bf16(v0[2], v0[3]); w.z = cvt_pk_bf16(v1[0], v1[1]); w.w = cvt_pk_bf16(v1[2], v1[3]);
                    *(u32x4*)(O + (size_t)row * ldc + col0 + bj * HALF) = w; } }
    }
};
struct EpiSilu {
    static constexpr bool PERM = true;
    bf16_t* O; const float* posb;
    __device__ __forceinline__ void operator()(const f32x4 (&acc)[2][2][4][2], const Unit& u, int wr, int wc, int fr, int fq, PG8_LAS const float* rs_tab) const {
        const int row0 = u.pm * BM + wr * 64 + fr; const int col0 = wc * 32 + 8 * fq;
#pragma unroll
        for (int bj = 0; bj < 2; ++bj) { const f32x4 b0 = *(const f32x4*)(posb + u.pn * 256 + col0 + bj * HALF), b1 = *(const f32x4*)(posb + u.pn * 256 + col0 + bj * HALF + 4);
#pragma unroll
            for (int ai = 0; ai < 2; ++ai)
#pragma unroll
                for (int m = 0; m < 4; ++m) { const int row = row0 + ai * HALF + m * 16; f32x4 v0 = acc[ai][bj][m][0] + b0, v1 = acc[ai][bj][m][1] + b1;
#pragma unroll
                    for (int e = 0; e < 4; ++e) { v0[e] = v0[e] / (1.f + __expf(-v0[e])); v1[e] = v1[e] / (1.f + __expf(-v1[e])); }
                    u32x4 w; w.x = cvt_pk_bf16(v0[0], v0[1]); w.y = cvt_pk_bf16(v0[2], v0[3]); w.z = cvt_pk_bf16(v1[0], v1[1]); w.w = cvt_pk_bf16(v1[2], v1[3]);
                    *(u32x4*)(O + (size_t)row * 256 + col0 + bj * HALF) = w; } }
    }
};
template <int MODE> struct EpiResT {
    static constexpr bool PERM = true;
    const float* base; float* out; bf16_t* xb; bf16_t* xl; float* ssq;
    __device__ __forceinline__ static void unpack8(const u32x4 a, const u32x4 b, f32x4& h0, f32x4& h1) {
        h0[0] = __builtin_bit_cast(float, a.x << 16) + __builtin_bit_cast(float, b.x << 16); h0[1] = __builtin_bit_cast(float, a.x & 0xffff0000u) + __builtin_bit_cast(float, b.x & 0xffff0000u);
        h0[2] = __builtin_bit_cast(float, a.y << 16) + __builtin_bit_cast(float, b.y << 16); h0[3] = __builtin_bit_cast(float, a.y & 0xffff0000u) + __builtin_bit_cast(float, b.y & 0xffff0000u);
        h1[0] = __builtin_bit_cast(float, a.z << 16) + __builtin_bit_cast(float, b.z << 16); h1[1] = __builtin_bit_cast(float, a.z & 0xffff0000u) + __builtin_bit_cast(float, b.z & 0xffff0000u);
        h1[2] = __builtin_bit_cast(float, a.w << 16) + __builtin_bit_cast(float, b.w << 16); h1[3] = __builtin_bit_cast(float, a.w & 0xffff0000u) + __builtin_bit_cast(float, b.w & 0xffff0000u);
    }
    __device__ __forceinline__ void operator()(const f32x4 (&acc)[2][2][4][2], const Unit& u, int wr, int wc, int fr, int fq, PG8_LAS const float* rs_tab) const {
        const int row0 = u.pm * BM + wr * 64 + fr, col0 = u.pn * BM + wc * 32 + 8 * fq;
#pragma unroll
        for (int ai = 0; ai < 2; ++ai) {
            u32x4 pre[4][2][2];
#pragma unroll
            for (int m = 0; m < 4; ++m) { const size_t off = (size_t)(row0 + ai * HALF + m * 16) * 1024 + col0;
#pragma unroll
                for (int bj = 0; bj < 2; ++bj) {
                    if (MODE == 0) { pre[m][bj][0] = *(const u32x4*)(base + off + bj * HALF); pre[m][bj][1] = *(const u32x4*)(base + off + bj * HALF + 4); }
                    else { pre[m][bj][0] = *(const u32x4*)(xb + off + bj * HALF); pre[m][bj][1] = *(const u32x4*)(xl + off + bj * HALF); } } }
            asm volatile("" ::: "memory");
#pragma unroll
            for (int m = 0; m < 4; ++m) { const int row = row0 + ai * HALF + m * 16; const size_t off = (size_t)row * 1024 + col0; float q = 0.f;
#pragma unroll
                for (int bj = 0; bj < 2; ++bj) { f32x4 h0, h1;
                    if (MODE == 0) { h0 = __builtin_bit_cast(f32x4, pre[m][bj][0]); h1 = __builtin_bit_cast(f32x4, pre[m][bj][1]); } else unpack8(pre[m][bj][0], pre[m][bj][1], h0, h1);
                    h0 = h0 + acc[ai][bj][m][0]; h1 = h1 + acc[ai][bj][m][1];
                    if (MODE == 2) { *(f32x4*)(out + off + bj * HALF) = h0; *(f32x4*)(out + off + bj * HALF + 4) = h1; }
                    else { q += ((h0[0] * h0[0] + h0[1] * h0[1]) + (h0[2] * h0[2] + h0[3] * h0[3])) + ((h1[0] * h1[0] + h1[1] * h1[1]) + (h1[2] * h1[2] + h1[3] * h1[3]));
                        u32x4 w; w.x = cvt_pk_bf16(h0[0], h0[1]); w.y = cvt_pk_bf16(h0[2], h0[3]); w.z = cvt_pk_bf16(h1[0], h1[1]); w.w = cvt_pk_bf16(h1[2], h1[3]);
                        u32x4 l; l.x = cvt_pk_bf16(h0[0] - __builtin_bit_cast(float, w.x << 16), h0[1] - __builtin_bit_cast(float, w.x & 0xffff0000u)); l.y = cvt_pk_bf16(h0[2] - __builtin_bit_cast(float, w.y << 16), h0[3] - __builtin_bit_cast(float, w.y & 0xffff0000u));
                        l.z = cvt_pk_bf16(h1[0] - __builtin_bit_cast(float, w.z << 16), h1[1] - __builtin_bit_cast(float, w.z & 0xffff0000u)); l.w = cvt_pk_bf16(h1[2] - __builtin_bit_cast(float, w.w << 16), h1[3] - __builtin_bit_cast(float, w.w & 0xffff0000u));
                        *(u32x4*)(xb + off + bj * HALF) = w; *(u32x4*)(xl + off + bj * HALF) = l; } }
                if (MODE != 2) { q += __shfl_xor(q, 16); q += __shfl_xor(q, 32);
                    if (fq == 0) atomicAdd(ssq + row, q); } }
            asm volatile("" ::: "memory");
        }
    }
};
typedef EpiResT<0> EpiRes0;
typedef EpiResT<1> EpiRes1;
typedef EpiResT<2> EpiRes2;

template <class Epi, class Sched, bool ALIGN_EPI = false, bool SP2 = false>
__device__ __forceinline__ void gemm_phase(PG8_LAS unsigned char* lds, const Gemm g, const Sched& S, const Epi& E, const float* rowss = nullptr, PG8_LAS float* aux = nullptr) {
    const int tid = threadIdx.x, wid = __builtin_amdgcn_readfirstlane(tid >> 6), lane = tid & 63, wr = wid >> 2, wc = wid & 3, fr = lane & 15, fq = lane >> 4;
    const int K = g.K, nt = K / BK, lda = g.lda;
    unsigned voffA[2], voffB[2];
#pragma unroll
    for (int i = 0; i < 2; ++i) { int R, C; stage_rc(tid * 16 + i * 8192, R, C); const int Rb = Epi::PERM ? ((R & ~31) + perm32(R & 31)) : R;
        voffA[i] = (unsigned)(R * lda + C) * 2u; voffB[i] = (unsigned)(Rb * K + C) * 2u; }
    const size_t kstep = (size_t)(BK * 2);
    const size_t hstepA = (size_t)HALF * lda * 2, hstepB = (size_t)HALF * K * 2;
    const size_t tstepA = 2 * hstepA, tstepB = 2 * hstepB;
    const unsigned ldsw = (unsigned)wid * 1024u;
    const int aoff = lds_byte(wr * 64 + fr, fq * 8), boff = lds_byte(wc * 32 + fr, fq * 8);
#define PG8_SA(b, h) (((b) * 2 + (h)) * HTB)
#define PG8_SB(b, h) ((4 + (b) * 2 + (h)) * HTB)
#define PG8_STAGE(bufoff, gbase, voff) do { _Pragma("unroll") for (int _i = 0; _i < 2; ++_i) \
        __builtin_amdgcn_global_load_lds((const unsigned*)((const char*)(gbase) + (voff)[_i]), (PG8_LAS unsigned*)(lds + (bufoff) + ldsw + _i * 8192), 16, 0, 0); } while (0)
#define PG8_LDA(dst, b, h) do { _Pragma("unroll") for (int m = 0; m < 4; ++m) _Pragma("unroll") for (int k = 0; k < 2; ++k) dst[m][k] = *(const PG8_LAS bf16x8*)(lds + PG8_SA(b, h) + aoff + m * 2048 + k * 1024); } while (0)
#define PG8_LDB(dst, b, h) do { _Pragma("unroll") for (int n = 0; n < 2; ++n) _Pragma("unroll") for (int k = 0; k < 2; ++k) dst[n][k] = *(const PG8_LAS bf16x8*)(lds + PG8_SB(b, h) + boff + n * 2048 + k * 1024); } while (0)
#define PG8_MMA(ai, bj, At, Bt) do { __builtin_amdgcn_s_setprio(1); _Pragma("unroll") for (int m = 0; m < 4; ++m) _Pragma("unroll") for (int n = 0; n < 2; ++n) _Pragma("unroll") for (int k = 0; k < 2; ++k) \
        acc[ai][bj][m][n] = __builtin_amdgcn_mfma_f32_16x16x32_bf16(Bt[n][k], At[m][k], acc[ai][bj][m][n], 0, 0, 0); __builtin_amdgcn_s_setprio(0); } while (0)
#define PG8_WAIT_V(n) asm volatile("s_waitcnt vmcnt(" #n ")" ::: "memory")
#define PG8_WAIT_L(n) asm volatile("s_waitcnt lgkmcnt(" #n ")" ::: "memory")
#define PG8_BAR __builtin_amdgcn_s_barrier()
#define PG8_SCHED __builtin_amdgcn_sched_barrier(0)
    Unit cur, nxt; int ui = 0;
    if (!S.next(0, cur)) return;
    f32x4 acc[2][2][4][2];
#pragma unroll
    for (int a = 0; a < 2; ++a)
#pragma unroll
        for (int b = 0; b < 2; ++b)
#pragma unroll
            for (int m = 0; m < 4; ++m)
#pragma unroll
                for (int n = 0; n < 2; ++n) acc[a][b][m][n] = (f32x4){0.f, 0.f, 0.f, 0.f};
    bf16x8 At[4][2], B0[2][2], B1[2][2];
    const char* cA = (const char*)g.A + (size_t)cur.pm * tstepA; const char* cB = (const char*)g.Bt + (size_t)cur.pn * tstepB;
    if (rowss && tid < 256) aux[tid] = __builtin_amdgcn_rsqf(rowss[cur.pm * BM + tid] * (1.0f / 1024.0f) + 1e-5f);
    if constexpr (SP2) {
        PG8_STAGE(PG8_SB(0, 0), cB, voffB); PG8_STAGE(PG8_SB(0, 1), cB + hstepB, voffB); PG8_STAGE(PG8_SA(0, 0), cA, voffA); PG8_STAGE(PG8_SA(0, 1), cA + hstepA, voffA);
        if (wr == 1) PG8_BAR;
        PG8_WAIT_V(2); PG8_BAR;
        PG8_STAGE(PG8_SB(1, 0), cB + kstep, voffB); PG8_STAGE(PG8_SA(1, 0), cA + kstep, voffA); PG8_STAGE(PG8_SB(1, 1), cB + hstepB + kstep, voffB);
        PG8_WAIT_V(6); PG8_BAR;
    } else {
        PG8_STAGE(PG8_SB(0, 0), cB, voffB); PG8_STAGE(PG8_SA(0, 0), cA, voffA); PG8_STAGE(PG8_SB(0, 1), cB + hstepB, voffB); PG8_STAGE(PG8_SA(0, 1), cA + hstepA, voffA);
        if (wr == 1) PG8_BAR;
        PG8_WAIT_V(4); PG8_BAR;
        PG8_STAGE(PG8_SB(1, 0), cB + kstep, voffB); PG8_STAGE(PG8_SA(1, 0), cA + kstep, voffA); PG8_STAGE(PG8_SB(1, 1), cB + hstepB + kstep, voffB);
        PG8_WAIT_V(6); PG8_BAR;
    }
    for (;;) {
        const bool has_next = S.next(ui + 1, nxt);
        const char* nA = has_next ? (const char*)g.A + (size_t)nxt.pm * tstepA : cA; const char* nB = has_next ? (const char*)g.Bt + (size_t)nxt.pn * tstepB : cB;
        for (int t = 0; t < nt; t += 2) {
            const bool last = (t == nt - 2);
            const char* a1 = cA + (size_t)(t + 1) * kstep;
            const char* a2 = last ? nA : cA + (size_t)(t + 2) * kstep; const char* b2 = last ? nB : cB + (size_t)(t + 2) * kstep;
            const char* a3 = a2 + kstep; const char* b3 = b2 + kstep;
            if constexpr (SP2) {
            PG8_LDB(B0, 0, 0); PG8_LDB(B1, 0, 1); PG8_SCHED; PG8_LDA(At, 0, 0); PG8_STAGE(PG8_SA(1, 1), a1 + hstepA, voffA);
            PG8_WAIT_V(8); PG8_WAIT_L(0); PG8_BAR; PG8_MMA(0, 0, At, B0); PG8_MMA(0, 1, At, B1); PG8_BAR; PG8_SCHED;
            PG8_LDA(At, 0, 1); PG8_STAGE(PG8_SB(0, 0), b2, voffB); PG8_STAGE(PG8_SB(0, 1), b2 + hstepB, voffB); PG8_STAGE(PG8_SA(0, 0), a2, voffA);
            PG8_WAIT_V(8); PG8_WAIT_L(0); PG8_BAR; PG8_MMA(1, 0, At, B0); PG8_MMA(1, 1, At, B1); PG8_BAR; PG8_SCHED;
            PG8_LDB(B0, 1, 0); PG8_LDB(B1, 1, 1); PG8_SCHED; PG8_LDA(At, 1, 0); PG8_STAGE(PG8_SA(0, 1), a2 + hstepA, voffA);
            PG8_WAIT_V(8); PG8_WAIT_L(0); PG8_BAR; PG8_MMA(0, 0, At, B0); PG8_MMA(0, 1, At, B1); PG8_BAR; PG8_SCHED;
            PG8_LDA(At, 1, 1); PG8_STAGE(PG8_SB(1, 0), b3, voffB); PG8_STAGE(PG8_SB(1, 1), b3 + hstepB, voffB); PG8_STAGE(PG8_SA(1, 0), a3, voffA);
            PG8_WAIT_V(8); PG8_WAIT_L(0); PG8_BAR; PG8_MMA(1, 0, At, B0); PG8_MMA(1, 1, At, B1); PG8_BAR; PG8_SCHED;
            } else {
            PG8_LDB(B0, 0, 0); PG8_SCHED; PG8_LDA(At, 0, 0); PG8_STAGE(PG8_SA(1, 1), a1 + hstepA, voffA);
            PG8_WAIT_L(8); PG8_BAR; PG8_WAIT_L(0); PG8_MMA(0, 0, At, B0); PG8_BAR; PG8_SCHED;
            PG8_LDB(B1, 0, 1); PG8_STAGE(PG8_SB(0, 0), b2, voffB);
            PG8_BAR; PG8_WAIT_L(0); PG8_MMA(0, 1, At, B1); PG8_BAR;
            PG8_LDA(At, 0, 1); PG8_STAGE(PG8_SA(0, 0), a2, voffA);
            PG8_BAR; PG8_WAIT_L(0); PG8_MMA(1, 0, At, B0); PG8_BAR; PG8_SCHED;
            PG8_STAGE(PG8_SB(0, 1), b2 + hstepB, voffB);
            PG8_WAIT_V(6); PG8_BAR; PG8_MMA(1, 1, At, B1); PG8_BAR;
            PG8_LDB(B0, 1, 0); PG8_SCHED; PG8_LDA(At, 1, 0); PG8_STAGE(PG8_SA(0, 1), a2 + hstepA, voffA);
            PG8_WAIT_L(8); PG8_BAR; PG8_WAIT_L(0); PG8_MMA(0, 0, At, B0); PG8_BAR; PG8_SCHED;
            PG8_LDB(B1, 1, 1); PG8_STAGE(PG8_SB(1, 0), b3, voffB);
            PG8_BAR; PG8_WAIT_L(0); PG8_MMA(0, 1, At, B1); PG8_BAR;
            PG8_LDA(At, 1, 1); PG8_STAGE(PG8_SA(1, 0), a3, voffA);
            PG8_BAR; PG8_WAIT_L(0); PG8_MMA(1, 0, At, B0); PG8_BAR; PG8_SCHED;
            PG8_STAGE(PG8_SB(1, 1), b3 + hstepB, voffB);
            PG8_WAIT_V(6); PG8_BAR; PG8_MMA(1, 1, At, B1); PG8_BAR;
            }
        }
        if constexpr (ALIGN_EPI) { if (wr == 0) PG8_BAR; }
        E(acc, cur, wr, wc, fr, fq, aux + (ui & 1) * 256);
        if (!has_next) break;
#pragma unroll
        for (int a = 0; a < 2; ++a)
#pragma unroll
            for (int b = 0; b < 2; ++b)
#pragma unroll
                for (int m = 0; m < 4; ++m)
#pragma unroll
                    for (int n = 0; n < 2; ++n) acc[a][b][m][n] = (f32x4){0.f, 0.f, 0.f, 0.f};
        cur = nxt; cA = nA; cB = nB; ++ui;
        if (rowss && tid < 256) aux[(ui & 1) * 256 + tid] = __builtin_amdgcn_rsqf(rowss[cur.pm * BM + tid] * (1.0f / 1024.0f) + 1e-5f);
        if constexpr (ALIGN_EPI) { if (wr == 1) PG8_BAR; }
    }
    PG8_WAIT_V(0);
    if constexpr (!ALIGN_EPI) { if (wr == 0) PG8_BAR; }
    PG8_BAR;
#undef PG8_SA
#undef PG8_SB
#undef PG8_STAGE
#undef PG8_LDA
#undef PG8_LDB
#undef PG8_MMA
#undef PG8_WAIT_V
#undef PG8_WAIT_L
#undef PG8_BAR
#undef PG8_SCHED
}
}
constexpr int NWAVES = 8;
constexpr int BATCH = 8, SEQ = 4096, DM = 1024, FF = 4096, M = BATCH * SEQ;
constexpr int N0 = 2816, N0G = 3072, N0SRC = 2840, N1 = 3072, N1SRC = 3088;
constexpr int C_MQ = 0, C_MK = 512, C_MV = 1024, C_NQ = 1536, C_KSL = 2304, C_VSL = 2432, C_KWN = 2560, C_VWN = 2688;
constexpr int C_FQ = 0, C_FK = 1024, C_FV = 2048;
constexpr float LOG2E = 1.4426950408889634f;
constexpr float C2 = 0.125f * LOG2E;

constexpr size_t MiB = 1u << 20;
constexpr size_t WS_CTL = 0, CTL_ZERO_BYTES = 1 * MiB;
constexpr size_t WS_WIN0 = 1 * MiB;
constexpr size_t WS_WOUT0 = WS_WIN0 + (size_t)N0G * 1024 * 2;
constexpr size_t WS_W1_0 = WS_WOUT0 + 2 * MiB;
constexpr size_t WS_W2_0 = WS_W1_0 + 8 * MiB;
constexpr size_t WS_WIN1 = WS_W2_0 + 8 * MiB;
constexpr size_t WS_WOUT1 = WS_WIN1 + 6 * MiB;
constexpr size_t WS_W1_1 = WS_WOUT1 + 2 * MiB;
constexpr size_t WS_W2_1 = WS_W1_1 + 8 * MiB;
constexpr size_t WS_WCMP = WS_W2_1 + 8 * MiB;
constexpr size_t WS_WG0 = WS_WCMP + 2 * MiB;
constexpr size_t WS_WF1 = WS_WG0 + 65536;
constexpr size_t WS_TB = WS_WF1 + 65536;
constexpr size_t WS_POSB = WS_TB + 65536;
constexpr size_t WS_W2T = WS_POSB + 4096;
constexpr size_t WS_SSQ = WS_W2T + 65536;
constexpr size_t WS_KMEAN = WS_SSQ + 4 * (size_t)M * 4;
constexpr size_t WS_MSEL = WS_KMEAN + 8 * 8 * 16 * 64 * 4;
constexpr size_t WS_SSEL = WS_MSEL + 8 * 8 * 4096 * 4;
constexpr size_t WS_GZ = WS_SSEL + 8 * 2 * 4096 * 8;
constexpr size_t WS_CK = WS_GZ + (size_t)M * 32 * 4;
constexpr size_t WS_CMPIN = WS_CK + 8 * 16 * 4096 * 4;
constexpr size_t WS_HID = WS_CMPIN + 2 * 16 * 4096 * 64 * 2 + 65536;
constexpr size_t WS_KVCMP = WS_HID + 8192 * 256 * 2;
constexpr size_t WS_OCMP = ((WS_KVCMP + 2 * 16 * 256 * 64 * 2 + MiB - 1) / MiB) * MiB;
constexpr size_t WS_KNT = WS_MSEL;
constexpr size_t WS_RT = WS_MSEL + 65536;
constexpr size_t WS_XL = WS_OCMP;
constexpr size_t WS_XB = WS_OCMP + (size_t)M * 512 * 4;
constexpr size_t WS_P = WS_XB + (size_t)M * 1024 * 2;
constexpr size_t WS_O = WS_P + (size_t)M * 3072 * 2;
constexpr size_t WS_A = WS_P;
constexpr size_t WS_END = WS_O + (size_t)M * 1024 * 2;
constexpr int CW_BAR = 4096, CW_QFOX = 8192, CW_QMOBA = 8256, CW_QNSA = 8320, CW_CMPDONE = 8384;

constexpr int RING_OFF = 0, RING_BYTES = 143360;
constexpr int LDSCTL_OFF = RING_BYTES, MISC_OFF = LDSCTL_OFF + 320;
constexpr int LDS_BYTES = 147456;

#define GAS __attribute__((address_space(1)))
#define LAS __attribute__((address_space(3)))
typedef unsigned short bf16;
typedef unsigned v4u __attribute__((ext_vector_type(4)));
typedef float f32x4 __attribute__((ext_vector_type(4)));
typedef float f32x16 __attribute__((ext_vector_type(16)));
typedef short bf16x8 __attribute__((ext_vector_type(8)));
typedef GAS unsigned gu32;
#define RLX_AGENT __ATOMIC_RELAXED, __HIP_MEMORY_SCOPE_AGENT
#define LDS_WAIT() asm volatile("s_waitcnt lgkmcnt(0)" ::: "memory")
#define VM_WAIT() asm volatile("s_waitcnt vmcnt(0)" ::: "memory")
__device__ __forceinline__ unsigned f2bf(float f) { unsigned u = __builtin_bit_cast(unsigned, f); return (u + 0x7fffu + ((u >> 16) & 1u)) >> 16; }
__device__ __forceinline__ unsigned pk2(float lo, float hi) { return f2bf(lo) | (f2bf(hi) << 16); }
__device__ __forceinline__ float bflo(unsigned w) { return __builtin_bit_cast(float, w << 16); }
__device__ __forceinline__ float bfhi(unsigned w) { return __builtin_bit_cast(float, w & 0xffff0000u); }
__device__ __forceinline__ float bf2f(bf16 h) { return __builtin_bit_cast(float, (unsigned)h << 16); }

#define XB_TMO      128
#define XB_XCNT(j)  (256  + 64 * (j))
#define XB_XSUB(j)  (1280 + 64 * (j))
#define XB_XGEN(j)  (2304 + 64 * (j))
#define XB_TOP      3328
#define XB_TOPGEN   3392
#define XCD_BAR_WORDS 3456
#define XB_SPIN_CAP (1u << 20)
__device__ __forceinline__ unsigned xb_ld(unsigned* p)              { return __hip_atomic_load(p, __ATOMIC_RELAXED, __HIP_MEMORY_SCOPE_AGENT); }
__device__ __forceinline__ unsigned xb_add(unsigned* p, unsigned v) { return __hip_atomic_fetch_add(p, v, __ATOMIC_RELAXED, __HIP_MEMORY_SCOPE_AGENT); }
__device__ __forceinline__ unsigned xb_xcc_id() { return (unsigned)__builtin_amdgcn_s_getreg((3 << 11) | 20) & 0xFu; }
#define XB_SPIN(cond, bar) do { unsigned _sp = 0; while (cond) { __builtin_amdgcn_s_sleep(1); \
    if ((++_sp & 255u) == 0u) { if (xb_ld(&(bar)[XB_TMO])) break; if (_sp > XB_SPIN_CAP) { atomicAdd(&(bar)[XB_TMO], 1u); break; } } } } while (0)
struct XcdBarrier { unsigned* bar; unsigned x; volatile LAS unsigned* st; };
__device__ __forceinline__ XcdBarrier xcd_barrier_post(unsigned* bar, volatile LAS unsigned* st) {
    XcdBarrier b; b.bar = bar; b.x = xb_xcc_id(); b.st = st;
    if (threadIdx.x == 0) (void)xb_add(&bar[XB_XCNT(b.x)], 1u);
    return b;
}
__device__ __forceinline__ void xcd_barrier_complete(unsigned* bar, unsigned x, unsigned& nloc, unsigned& nx) {
    const unsigned G = gridDim.x * gridDim.y * gridDim.z;
    unsigned sum, cnt, mine, sp = 0u;
    for (;;) {
        sum = 0u; cnt = 0u; mine = 0u;
#pragma unroll
        for (unsigned j = 0; j < 16; ++j) { const unsigned c = xb_ld(&bar[XB_XCNT(j)]); sum += c; cnt += (c > 0u) ? 1u : 0u; mine = (j == x) ? c : mine; }
        if (sum == G) break;
        __builtin_amdgcn_s_sleep(1);
        if ((++sp & 255u) == 0u) { if (xb_ld(&bar[XB_TMO])) break; if (sp > XB_SPIN_CAP) { atomicAdd(&bar[XB_TMO], 1u); break; } }
    }
    nloc = mine > 0u ? mine : 1u; nx = cnt > 0u ? cnt : 1u;
}
__device__ __forceinline__ void xcd_barrier(const XcdBarrier& b) {
    asm volatile("s_waitcnt vmcnt(0)" ::: "memory");
    __syncthreads();
    if (threadIdx.x == 0) {
        unsigned* bar = b.bar;
        __builtin_amdgcn_s_waitcnt(0);
        unsigned nloc = b.st[0], nx = b.st[1];
        if (nloc == 0u) { xcd_barrier_complete(bar, b.x, nloc, nx); b.st[0] = nloc; b.st[1] = nx; }
        const unsigned old = xb_add(&bar[XB_XSUB(b.x)], 1u);
        const unsigned gen = old / nloc;
        if (old + 1u == (gen + 1u) * nloc) {
            __builtin_amdgcn_fence(__ATOMIC_RELEASE, "agent");
            asm volatile("s_waitcnt vmcnt(0)" ::: "memory");
            const unsigned og = xb_add(&bar[XB_TOP], 1u);
            const unsigned tg = og / nx;
            if (og + 1u == (tg + 1u) * nx) xb_add(&bar[XB_TOPGEN], 1u);
            else XB_SPIN(xb_ld(&bar[XB_TOPGEN]) == tg, bar);
            __builtin_amdgcn_fence(__ATOMIC_ACQUIRE, "agent");
            xb_add(&bar[XB_XGEN(b.x)], 1u);
            asm volatile("s_waitcnt vmcnt(0)" ::: "memory");
        } else {
            XB_SPIN(xb_ld(&bar[XB_XGEN(b.x)]) == gen, bar);
            __builtin_amdgcn_fence(__ATOMIC_ACQUIRE, "agent");
            asm volatile("s_waitcnt vmcnt(0)" ::: "memory");
        }
    }
    __syncthreads();
}

struct Frame {
    LAS unsigned char* lds;
    volatile LAS unsigned* MISC;
    gu32* ctl;
    int tid, lane, wave;
    int vcu, G;
    int gw, NGW;
    unsigned char* ws;
};

__device__ __forceinline__ float wave_sum(float v) {
#pragma unroll
    for (int o = 1; o < 64; o <<= 1) v += __shfl_xor(v, o);
    return v;
}
__device__ __forceinline__ float wave_max(float v) {
#pragma unroll
    for (int o = 1; o < 64; o <<= 1) v = fmaxf(v, __shfl_xor(v, o));
    return v;
}
struct TrItem { const float* W; int K, Nsrc, Nuse; const float* gk; bf16* WT; int row_off, item; };
__device__ __forceinline__ void tr_load(const TrItem& d, int lane, f32x4 (&v)[8]) {
    const int nblk = d.Nuse / 32, kb = d.item / nblk, nb = d.item % nblk, k0 = 64 * kb, n0 = 32 * nb;
#pragma unroll
    for (int i = 0; i < 8; ++i) { const int kk = 8 * i + (lane >> 3); v[i] = *(const f32x4*)(d.W + (size_t)(k0 + kk) * d.Nsrc + n0 + 4 * (lane & 7)); if (d.gk) v[i] = v[i] * d.gk[k0 + kk]; }
}
__device__ __forceinline__ void tr_finish(const TrItem& d, int lane, const f32x4 (&v)[8], LAS float* scr) {
    const int nblk = d.Nuse / 32, kb = d.item / nblk, nb = d.item % nblk, k0 = 64 * kb, n0 = 32 * nb;
#pragma unroll
    for (int i = 0; i < 8; ++i) { const int kk = 8 * i + (lane >> 3); LAS float* t = scr + kk * 33 + 4 * (lane & 7); t[0] = v[i].x; t[1] = v[i].y; t[2] = v[i].z; t[3] = v[i].w; }
    LDS_WAIT(); asm volatile("" ::: "memory");
    const int c = lane & 7;
#pragma unroll
    for (int j = 0; j < 4; ++j) { const int n = (lane >> 3) + 8 * j; const LAS float* s = scr + (8 * c) * 33 + n;
        v4u o; o.x = pk2(s[0 * 33], s[1 * 33]); o.y = pk2(s[2 * 33], s[3 * 33]); o.z = pk2(s[4 * 33], s[5 * 33]); o.w = pk2(s[6 * 33], s[7 * 33]);
        *(GAS v4u*)(d.WT + (size_t)(d.row_off + n0 + n) * d.K + k0 + 8 * c) = o; }
    LDS_WAIT(); asm volatile("" ::: "memory");
}
__device__ __forceinline__ int t5_bucket(int d) {
    if (d < 16) return d;
    int b = 16;
    b += (d >= 21); b += (d >= 27); b += (d >= 35); b += (d >= 46); b += (d >= 59); b += (d >= 77); b += (d >= 99); b += (d >= 128);
    b += (d >= 166); b += (d >= 216); b += (d >= 280); b += (d >= 363); b += (d >= 470); b += (d >= 609); b += (d >= 790);
    return b;
}
struct Args { const float* in[18]; float* out; unsigned char* ws; int ph_lo, ph_hi; };
template <int BYTE_OFF> __device__ __forceinline__ const float* karg() {
    const char* ka = (const char*)__builtin_amdgcn_kernarg_segment_ptr(); unsigned long long v;
    asm volatile("s_load_dwordx2 %0, %1, %2\n\ts_waitcnt lgkmcnt(0)" : "=s"(v) : "s"(ka), "i"(BYTE_OFF));
    return (const float*)v;
}
#define KIN(k) karg<8 * (k)>()
#define KOUT() ((float*)karg<8 * 18>())
enum { I_X = 0, I_RELB, I_MIXN, I_MLPN, I_EWIN, I_EWOUT, I_POSK, I_POSV, I_CKW1, I_CKW2, I_CVW1, I_CVW2, I_OWIN, I_OBF, I_OWOUT, I_MW1, I_MW2, I_FN };

__device__ __forceinline__ void p0_prologue(Frame& F, const Args& a) {
    unsigned char* ws = F.ws;
    auto stream_x = [&](int m0, int m1, int xw, int NXW) __attribute__((always_inline)) {
#pragma unroll 1
        for (int m = m0 + xw; m < m1; m += 4 * NXW) {
            f32x4 v[4][4];
#pragma unroll
            for (int q = 0; q < 4; ++q) { const int mm = (m + q * NXW < m1) ? m + q * NXW : m; const GAS f32x4* xr = (const GAS f32x4*)(KIN(I_X) + (size_t)mm * 1024) + F.lane;
#pragma unroll
                for (int j = 0; j < 4; ++j) v[q][j] = __builtin_nontemporal_load(xr + 64 * j); }
            asm volatile("" ::: "memory");
#pragma unroll
            for (int q = 0; q < 4; ++q) { const int mm = m + q * NXW; if (mm < m1) {
                GAS unsigned long long* o8 = (GAS unsigned long long*)((bf16*)(ws + WS_XB) + (size_t)mm * 1024) + F.lane; float s = 0.f;
#pragma unroll
                for (int j = 0; j < 4; ++j) { const f32x4 w = v[q][j]; s += (w.x * w.x + w.y * w.y) + (w.z * w.z + w.w * w.w);
                    o8[64 * j] = (unsigned long long)pk2(w.x, w.y) | ((unsigned long long)pk2(w.z, w.w) << 32); }
                s = wave_sum(s); if (F.lane == 0) ((float*)(ws + WS_SSQ))[mm] = s; } }
        }
    };
    constexpr int M_MAIN = M;
    if (F.wave < 6) { stream_x(0, M_MAIN, F.vcu * 6 + F.wave, F.G * 6); return; }
    const int sw = F.vcu * 2 + (F.wave - 6), NSW = F.G * 2;
    LAS float* scr = (LAS float*)(F.lds + RING_OFF + F.wave * 16384);
    constexpr int I_IN0 = 16 * (N0 / 32), I_CW = 32 * 8;
    auto p0_item = [&](int r) __attribute__((always_inline)) -> TrItem {
        if (r < I_IN0) return TrItem{KIN(I_EWIN), 1024, N0SRC, N0, KIN(I_MIXN), (bf16*)(ws + WS_WIN0), 0, r};
        r -= I_IN0;
        if (r < I_CW) return TrItem{KIN(I_CKW1), 2048, 256, 256, nullptr, (bf16*)(ws + WS_WCMP), 0, r};
        return TrItem{KIN(I_CVW1), 2048, 256, 256, nullptr, (bf16*)(ws + WS_WCMP), 256, r - I_CW}; };
    for (int it = sw; it < I_IN0 + 2 * I_CW; it += 2 * NSW) {
        const bool two = it + NSW < I_IN0 + 2 * I_CW;
        const TrItem d0 = p0_item(it), d1 = p0_item(two ? it + NSW : it);
        f32x4 v0[8], v1[8]; tr_load(d0, F.lane, v0); if (two) tr_load(d1, F.lane, v1);
        asm volatile("" ::: "memory");
        tr_finish(d0, F.lane, v0, scr); if (two) tr_finish(d1, F.lane, v1, scr);
    }
    const int gt = sw * 64 + F.lane, NGT = NSW * 64;
    for (int i0 = gt; i0 < 256 * 1024; i0 += 8 * NGT) { float v[8];
#pragma unroll
        for (int q = 0; q < 8; ++q) { const int i = i0 + q * NGT, n = i >> 10, k = i & 1023; v[q] = 0.f;
            if (i < 256 * 1024 && n < 24) v[q] = KIN(I_EWIN)[(size_t)k * N0SRC + N0 + n] * KIN(I_MIXN)[k]; }
        asm volatile("" ::: "memory");
#pragma unroll
        for (int q = 0; q < 8; ++q) { const int i = i0 + q * NGT, n = i >> 10, k = i & 1023;
            if (i < 256 * 1024) ((bf16*)(ws + WS_WIN0))[(size_t)(N0 + n) * 1024 + k] = (bf16)f2bf(v[q]); } }
    for (int i = gt; i < 32 * 1024; i += NGT) { const int n = i >> 10, k = i & 1023; float v = 0.f;
        if (n < 16) v = KIN(I_OWIN)[(size_t)k * N1SRC + N1 + n] * KIN(I_MIXN)[1024 + k];
        ((bf16*)(ws + WS_WF1))[n * 1024 + k] = (bf16)f2bf(v); }
    for (int i = gt; i < 8 * 8 * 16 * 64; i += NGT) ((float*)(ws + WS_KMEAN))[i] = 0.f;
    for (int i = gt; i < 2 * 64 * 256; i += NGT) { const int w = i >> 14, d = (i >> 8) & 63, cc = i & 255; ((bf16*)(ws + WS_W2T))[i] = (bf16)f2bf((w ? KIN(I_CVW2) : KIN(I_CKW2))[cc * 64 + d]); }
    for (int i = gt; i < 16 * 1024; i += NGT) { const int h = i >> 10, d = i & 1023; ((float*)(ws + WS_TB))[i] = KIN(I_RELB)[t5_bucket(d) * 16 + h] * LOG2E; }
    for (int i = gt; i < 16 * 1280; i += NGT) { const int h = i / 1280, j = i - h * 1280; ((float*)(ws + WS_RT))[i] = (j < 1024) ? KIN(I_RELB)[t5_bucket(1023 - j) * 16 + h] * LOG2E : 0.f; }
    for (int i = NSW - 1 - sw; i < 512; i += NSW) { const int w = i >> 8, c = i & 255; const float* pos = (w ? KIN(I_POSV) : KIN(I_POSK)); const float* W1 = (w ? KIN(I_CVW1) : KIN(I_CKW1)); float s = 0.f;
#pragma unroll 8
        for (int k = 0; k < 32; ++k) s += pos[32 * F.lane + k] * W1[(size_t)(32 * F.lane + k) * 256 + c];
        s = wave_sum(s); if (F.lane == 0) ((float*)(ws + WS_POSB))[i] = s; }
    for (int i = gt; i < 3 * M; i += NGT) ((float*)(ws + WS_SSQ))[M + i] = 0.f;
    stream_x(M_MAIN, M, sw, NSW);
}

constexpr int LATE_SQ = 16 * 32, LATE_UP = 16 * 128, LATE_DN = 64 * 32, LATE_IN1 = 16 * (N1 / 32);
constexpr int LATE_ITEMS = LATE_SQ + LATE_UP + LATE_DN + LATE_IN1 + LATE_SQ + LATE_UP + LATE_DN, LATE_CHUNKS = (LATE_ITEMS + 63) / 64;
__device__ __forceinline__ void late_weight_chunk(Frame& F, int chunk) {
    LAS float* scr = (LAS float*)(F.lds + RING_OFF + F.wave * 16384); unsigned char* ws = F.ws;
    auto late_item = [&](int r) __attribute__((always_inline)) -> TrItem {
        if (r < LATE_SQ) return TrItem{KIN(I_EWOUT), 1024, 1024, 1024, nullptr, (bf16*)(ws + WS_WOUT0), 0, r};
        r -= LATE_SQ;
        if (r < LATE_UP) return TrItem{KIN(I_MW1), 1024, 4096, 4096, KIN(I_MLPN), (bf16*)(ws + WS_W1_0), 0, r};
        r -= LATE_UP;
        if (r < LATE_DN) return TrItem{KIN(I_MW2), 4096, 1024, 1024, nullptr, (bf16*)(ws + WS_W2_0), 0, r};
        r -= LATE_DN;
        if (r < LATE_IN1) return TrItem{KIN(I_OWIN), 1024, N1SRC, N1, KIN(I_MIXN) + 1024, (bf16*)(ws + WS_WIN1), 0, r};
        r -= LATE_IN1;
        if (r < LATE_SQ) return TrItem{KIN(I_OWOUT), 1024, 1024, 1024, nullptr, (bf16*)(ws + WS_WOUT1), 0, r};
        r -= LATE_SQ;
        if (r < LATE_UP) return TrItem{KIN(I_MW1) + (size_t)1024 * 4096, 1024, 4096, 4096, KIN(I_MLPN) + 1024, (bf16*)(ws + WS_W1_1), 0, r};
        r -= LATE_UP;
        return TrItem{KIN(I_MW2) + (size_t)4096 * 1024, 4096, 1024, 1024, nullptr, (bf16*)(ws + WS_W2_1), 0, r}; };
#pragma unroll 1
    for (int k = 0; k < 8; k += 2) { const int r = chunk * 64 + F.wave * 8 + k; if (r >= LATE_ITEMS) break;
        const bool two = r + 1 < LATE_ITEMS;
        const TrItem d0 = late_item(r), d1 = late_item(two ? r + 1 : r);
        f32x4 v0[8], v1[8]; tr_load(d0, F.lane, v0); if (two) tr_load(d1, F.lane, v1);
        asm volatile("" ::: "memory");
        tr_finish(d0, F.lane, v0, scr); if (two) tr_finish(d1, F.lane, v1, scr); }
}
__device__ __forceinline__ void skinny_gemm(Frame& F, const bf16* A, const bf16* Wt, const float* ssq, float* out) {
    typedef float f32x4_t __attribute__((ext_vector_type(4)));
    const int r16 = F.lane & 15, kg = F.lane >> 4;
    for (int it = F.gw; it < M / 16; it += F.NGW) {
        const int row0 = it * 16; f32x4_t acc = {0.f, 0.f, 0.f, 0.f};
        const bf16* ap = A + (size_t)(row0 + r16) * 1024 + kg * 8; const bf16* bp = Wt + (size_t)r16 * 1024 + kg * 8;
#pragma unroll 8
        for (int ks = 0; ks < 32; ++ks) { const bf16x8 av = *(const bf16x8*)(ap + ks * 32), bv = *(const bf16x8*)(bp + ks * 32); acc = __builtin_amdgcn_mfma_f32_16x16x32_bf16(av, bv, acc, 0, 0, 0); }
#pragma unroll
        for (int r = 0; r < 4; ++r) { const int row = row0 + 4 * kg + r; out[(size_t)row * 32 + r16] = acc[r] * __builtin_amdgcn_rsqf(ssq[row] * (1.0f / 1024.0f) + 1e-5f); }
    }
}

__device__ __forceinline__ void ph_fox_cum(Frame& F, const Args& a) {
    const float* FZ = (const float*)(F.ws + WS_GZ); float* CK = (float*)(F.ws + WS_CK); LAS float* sc = (LAS float*)(F.lds + RING_OFF);
    for (int it = F.vcu; it < 128; it += F.G) { const int b = it >> 4, h = it & 15; const float bfv = KIN(I_OBF)[h];
        float v[8]; float run = 0.f;
#pragma unroll
        for (int k = 0; k < 8; ++k) { const int t = F.tid * 8 + k; const float z = FZ[(size_t)(b * 4096 + t) * 32 + h] + bfv;
            const float ls = fminf(z, 0.f) - log1pf(__expf(-fabsf(z))); run += ls; v[k] = run; }
        sc[F.tid] = run; __syncthreads();
        for (int off = 1; off < 512; off <<= 1) { float add = (F.tid >= off) ? sc[F.tid - off] : 0.f; __syncthreads(); sc[F.tid] += add; __syncthreads(); }
        const float base = (F.tid > 0) ? sc[F.tid - 1] : 0.f;
#pragma unroll
        for (int k = 0; k < 8; ++k) CK[(size_t)it * 4096 + F.tid * 8 + k] = (base + v[k]) * LOG2E;
        __syncthreads(); }
}
__device__ __forceinline__ void ph_final_norm(Frame& F, const Args& a) {
    const GAS f32x4* gr = (const GAS f32x4*)(KIN(I_FN)) + F.lane;
    f32x4 gn[4];
#pragma unroll
    for (int j = 0; j < 4; ++j) gn[j] = gr[64 * j];
#pragma unroll 1
    for (int m = F.gw; m < M; m += 4 * F.NGW) {
        f32x4 v[4][4];
#pragma unroll
        for (int q = 0; q < 4; ++q) { const int mm = (m + q * F.NGW < M) ? m + q * F.NGW : m; const GAS f32x4* xr = (const GAS f32x4*)(KOUT() + (size_t)mm * 1024) + F.lane;
#pragma unroll
            for (int j = 0; j < 4; ++j) v[q][j] = xr[64 * j]; }
        asm volatile("" ::: "memory");
#pragma unroll
        for (int q = 0; q < 4; ++q) { const int mm = m + q * F.NGW; if (mm < M) { GAS f32x4* xw = (GAS f32x4*)(KOUT() + (size_t)mm * 1024) + F.lane; float s = 0.f;
#pragma unroll
            for (int j = 0; j < 4; ++j) s += (v[q][j].x * v[q][j].x + v[q][j].y * v[q][j].y) + (v[q][j].z * v[q][j].z + v[q][j].w * v[q][j].w);
            const float rs = 1.0f / sqrtf(wave_sum(s) * (1.0f / 1024.0f) + 1e-5f);
#pragma unroll
            for (int j = 0; j < 4; ++j) xw[64 * j] = v[q][j] * rs * gn[j]; } }
    }
}
namespace fa {
typedef short s16x4 __attribute__((ext_vector_type(4)));
typedef short v4i16_t __attribute__((ext_vector_type(4)));
typedef unsigned u32x4 __attribute__((ext_vector_type(4)));
typedef LAS const char* lds_cptr;
constexpr int SLOTB = 8192;
constexpr int L_K = 0, L_V = 2 * SLOTB, L_WS = 4 * SLOTB, L_OST = L_WS + NWAVES * 64 * 4, L_TB = L_OST + NWAVES * 8192, TB_STRIDE = 1280, L_CK = L_TB, L_IMP = L_TB + 4 * TB_STRIDE * 4 + 2048, L_SEL = L_IMP + 2 * 65 * 32 * 4, L_END = L_SEL + 64 * 8;
static_assert(L_END <= RING_BYTES, "flash LDS map");
constexpr float MASKV = -30000.0f, THR = 8.0f;
__device__ __forceinline__ int crow(int r, int hi) { return (r & 3) + 8 * (r >> 2) + 4 * hi; }
__device__ __forceinline__ unsigned cvtpk(float lo, float hi) { typedef float f2 __attribute__((ext_vector_type(2))); typedef __bf16 b2 __attribute__((ext_vector_type(2))); f2 v = {lo, hi}; b2 b = __builtin_convertvector(v, b2); return __builtin_bit_cast(unsigned, b); }
__device__ __forceinline__ s16x4 vtr(lds_cptr p) { return __builtin_bit_cast(s16x4, __builtin_amdgcn_ds_read_tr16_b64_v4i16((LAS v4i16_t*)p)); }
#define FA_BAR() asm volatile("s_waitcnt vmcnt(0) lgkmcnt(0)\n\ts_barrier" ::: "memory")

struct Ctx { int lane, r32, hi, wid; LAS unsigned char* shm; };

__device__ __forceinline__ void dma_kv(const Ctx& c, const bf16* Kg, const bf16* Vg, int pitch, int k0, int slot) {
    const bf16* ks = Kg + (size_t)(k0 + 8 * c.wid + (c.lane >> 3)) * pitch + ((c.lane & 7) ^ (c.lane >> 3)) * 8;
    const bf16* vs = Vg + (size_t)(k0 + 16 * (c.wid & 3) + (c.lane >> 2)) * pitch + (c.wid >> 2) * 32 + (c.lane & 3) * 8;
    __builtin_amdgcn_global_load_lds((const unsigned*)ks, (LAS unsigned*)(c.shm + L_K + slot * SLOTB + c.wid * 1024), 16, 0, 0);
    __builtin_amdgcn_global_load_lds((const unsigned*)vs, (LAS unsigned*)(c.shm + L_V + slot * SLOTB + c.wid * 1024), 16, 0, 0);
}
__device__ __forceinline__ void load_q(bf16x8 (&qr)[4], const bf16* qrow, int hi) {
#pragma unroll
    for (int d0 = 0; d0 < 4; ++d0) qr[d0] = *(const bf16x8*)(qrow + d0 * 16 + hi * 8);
}
struct State { f32x16 o[2]; float m, l, mt; };
__device__ __forceinline__ void reset(State& s) { s.o[0] = f32x16{}; s.o[1] = f32x16{}; s.m = 0.f; s.l = 0.f; s.mt = -1.0e30f; }

__device__ __forceinline__ void dma_k(const Ctx& c, const bf16* Kg, int pitch, int k0, int slot) {
    const bf16* ks = Kg + (size_t)(k0 + 8 * c.wid + (c.lane >> 3)) * pitch + ((c.lane & 7) ^ (c.lane >> 3)) * 8;
    __builtin_amdgcn_global_load_lds((const unsigned*)ks, (LAS unsigned*)(c.shm + L_K + slot * SLOTB + c.wid * 1024), 16, 0, 0);
}
__device__ __forceinline__ void dma_v(const Ctx& c, const bf16* Vg, int pitch, int k0, int slot) {
    const bf16* vs = Vg + (size_t)(k0 + 16 * (c.wid & 3) + (c.lane >> 2)) * pitch + (c.wid >> 2) * 32 + (c.lane & 3) * 8;
    __builtin_amdgcn_global_load_lds((const unsigned*)vs, (LAS unsigned*)(c.shm + L_V + slot * SLOTB + c.wid * 1024), 16, 0, 0);
}
__device__ __forceinline__ void dma_copy(const Ctx& c, const float* src, int lds_off, int pieces) {
    for (int p = c.wid; p < pieces; p += NWAVES)
        __builtin_amdgcn_global_load_lds((const unsigned*)(src + p * 256 + c.lane * 4), (LAS unsigned*)(c.shm + lds_off + p * 1024), 16, 0, 0);
}
__device__ __forceinline__ void qk_tile(const Ctx& c, int slot, const bf16x8 (&qr)[4], f32x16& c0, f32x16& c1) {
    const lds_cptr kb = (lds_cptr)(c.shm + L_K + slot * SLOTB) + c.r32 * 128;
#pragma unroll
    for (int d0 = 0; d0 < 4; ++d0) { const int co = ((2 * d0 + c.hi) ^ (c.r32 & 7)) * 16; const bf16x8 b0 = *(const LAS bf16x8*)(kb + co), b1 = *(const LAS bf16x8*)(kb + 4096 + co);
        c0 = __builtin_amdgcn_mfma_f32_32x32x16_bf16(b0, qr[d0], c0, 0, 0, 0); c1 = __builtin_amdgcn_mfma_f32_32x32x16_bf16(b1, qr[d0], c1, 0, 0, 0); }
}
__device__ __forceinline__ float max3a(float a, float b, float c) { float r; asm("v_max3_f32 %0, %1, %2, %3" : "=v"(r) : "v"(a), "v"(b), "v"(c)); return r; }
template <bool HAS_NEXT, bool ASMMAX, class Pol>
__device__ __forceinline__ void fa_step(const Ctx& c, Pol& pol, const bf16x8 (&qr)[4], State& st, f32x16& c0, f32x16& c1, f32x16& n0, f32x16& n1, int t, int slot, LAS float* wsf) {
    pol.mask(c0, c1, t);
    float rm;
    if (ASMMAX) { float a = max3a(c0[0], c0[1], c1[0]), b = max3a(c0[2], c0[3], c1[1]); a = max3a(a, c1[2], c1[3]);
#pragma unroll
        for (int r = 4; r < 16; r += 4) { a = max3a(a, c0[r], c0[r + 1]); b = max3a(b, c0[r + 2], c0[r + 3]); a = max3a(a, c1[r], c1[r + 1]); b = max3a(b, c1[r + 2], c1[r + 3]); }
        rm = max3a(a, b, b); }
    else { rm = fmaxf(c0[0], c1[0]);
#pragma unroll
        for (int r = 1; r < 16; ++r) rm = fmaxf(rm, fmaxf(c0[r], c1[r])); }
    { auto rr = __builtin_amdgcn_permlane32_swap(__float_as_uint(rm), __float_as_uint(rm), false, false); rm = fmaxf(__uint_as_float(rr[0]), __uint_as_float(rr[1])); }
    if constexpr (Pol::TRACK) pol.track(st, rm, t);
    if (__any(rm > THR)) {
        const float dl = fmaxf(rm, 0.f); st.m += dl;
#pragma unroll
        for (int r = 0; r < 16; ++r) { c0[r] -= dl; c1[r] -= dl; }
        const float f = __builtin_amdgcn_exp2f(-dl); st.l *= f;
        if (c.hi == 0) wsf[c.r32] = f;
        LDS_WAIT();
#pragma unroll
        for (int r = 0; r < 16; ++r) { const float fr = wsf[crow(r, c.hi)]; st.o[0][r] *= fr; st.o[1][r] *= fr; }
        LDS_WAIT();
    }
    if (HAS_NEXT) { pol.init(n0, n1, st.m, t + 1); qk_tile(c, slot ^ 1, qr, n0, n1); }
    float sacc = 0.f;
    const lds_cptr vp = (lds_cptr)(c.shm + L_V + slot * SLOTB) + ((c.lane >> 4) & 1) * 32 + (c.lane & 3) * 8 + (4 * c.hi + ((c.lane & 15) >> 2)) * 64;
    u32x4 pw[4];
#pragma unroll
    for (int r = 0; r < 16; ++r) { c0[r] = __builtin_amdgcn_exp2f(c0[r]); sacc += c0[r]; }
    pw[0] = (u32x4){cvtpk(c0[0], c0[1]), cvtpk(c0[2], c0[3]), cvtpk(c0[4], c0[5]), cvtpk(c0[6], c0[7])};
    pw[1] = (u32x4){cvtpk(c0[8], c0[9]), cvtpk(c0[10], c0[11]), cvtpk(c0[12], c0[13]), cvtpk(c0[14], c0[15])};
#pragma unroll
    for (int ks = 0; ks < 2; ++ks)
#pragma unroll
        for (int d0 = 0; d0 < 2; ++d0) { const s16x4 lo = vtr(vp + d0 * 4096 + ks * 1024), hh = vtr(vp + d0 * 4096 + ks * 1024 + 512);
            const bf16x8 vf = (bf16x8){lo[0], lo[1], lo[2], lo[3], hh[0], hh[1], hh[2], hh[3]};
            st.o[d0] = __builtin_amdgcn_mfma_f32_32x32x16_bf16(__builtin_bit_cast(bf16x8, pw[ks]), vf, st.o[d0], 0, 0, 0); }
#pragma unroll
    for (int r = 0; r < 16; ++r) { c1[r] = __builtin_amdgcn_exp2f(c1[r]); sacc += c1[r]; }
    st.l += sacc;
    pw[2] = (u32x4){cvtpk(c1[0], c1[1]), cvtpk(c1[2], c1[3]), cvtpk(c1[4], c1[5]), cvtpk(c1[6], c1[7])};
    pw[3] = (u32x4){cvtpk(c1[8], c1[9]), cvtpk(c1[10], c1[11]), cvtpk(c1[12], c1[13]), cvtpk(c1[14], c1[15])};
#pragma unroll
    for (int ks = 2; ks < 4; ++ks)
#pragma unroll
        for (int d0 = 0; d0 < 2; ++d0) { const s16x4 lo = vtr(vp + d0 * 4096 + ks * 1024), hh = vtr(vp + d0 * 4096 + ks * 1024 + 512);
            const bf16x8 vf = (bf16x8){lo[0], lo[1], lo[2], lo[3], hh[0], hh[1], hh[2], hh[3]};
            st.o[d0] = __builtin_amdgcn_mfma_f32_32x32x16_bf16(__builtin_bit_cast(bf16x8, pw[ks]), vf, st.o[d0], 0, 0, 0); }
}
template <class Pol>
__device__ __forceinline__ void issue_first(const Ctx& c, const Pol& pol, const bf16* Kg, const bf16* Vg, int pitch) {
    dma_k(c, Kg, pitch, pol.k0(0), 0); dma_v(c, Vg, pitch, pol.k0(0), 0);
    if (pol.nt > 1) dma_k(c, Kg, pitch, pol.k0(1), 1);
}
template <bool PRE = false, class Pol>
__device__ __forceinline__ void run_branch(const Ctx& c, Pol& pol, const bf16* Kg, const bf16* Vg, int pitch, const bf16x8 (&qr)[4], State& st) {
    const int NT = pol.nt;
    if (NT <= 0) return;
    LAS float* wsf = (LAS float*)(c.shm + L_WS) + c.wid * 64;
    if (!PRE) issue_first(c, pol, Kg, Vg, pitch);
    FA_BAR();
    f32x16 a0, a1, b0, b1;
    pol.init(a0, a1, st.m, 0); qk_tile(c, 0, qr, a0, a1);
    FA_BAR();
    int t = 0;
    for (; t + 2 < NT; t += 2) {
        dma_k(c, Kg, pitch, pol.k0(t + 2), 0); dma_v(c, Vg, pitch, pol.k0(t + 1), 1);
        fa_step<true, true>(c, pol, qr, st, a0, a1, b0, b1, t, 0, wsf);
        FA_BAR();
        if (t + 3 < NT) dma_k(c, Kg, pitch, pol.k0(t + 3), 1);
        dma_v(c, Vg, pitch, pol.k0(t + 2), 0);
        fa_step<true, true>(c, pol, qr, st, b0, b1, a0, a1, t + 1, 1, wsf);
        FA_BAR();
    }
    if (t + 1 < NT) {
        dma_v(c, Vg, pitch, pol.k0(t + 1), 1);
        fa_step<true, true>(c, pol, qr, st, a0, a1, b0, b1, t, 0, wsf);
        FA_BAR();
        fa_step<false, true>(c, pol, qr, st, b0, b1, a0, a1, t + 1, 1, wsf);
        FA_BAR();
    } else {
        fa_step<false, true>(c, pol, qr, st, a0, a1, b0, b1, t, 0, wsf);
        FA_BAR();
    }
}
template <class Pol>
__device__ __forceinline__ void run_branch_simple(const Ctx& c, Pol& pol, const bf16* Kg, const bf16* Vg, int pitch, const bf16x8 (&qr)[4], State& st) {
    const int NT = pol.nt;
    if (NT <= 0) return;
    LAS float* wsf = (LAS float*)(c.shm + L_WS) + c.wid * 64;
    dma_kv(c, Kg, Vg, pitch, pol.k0(0), 0);
    FA_BAR();
    for (int i = 0; i < NT; ++i) {
        if (i + 1 < NT) dma_kv(c, Kg, Vg, pitch, pol.k0(i + 1), (i & 1) ^ 1);
        f32x16 c0, c1;
        pol.init(c0, c1, st.m, i); qk_tile(c, i & 1, qr, c0, c1);
        fa_step<false, false>(c, pol, qr, st, c0, c1, c0, c1, i, i & 1, wsf);
        FA_BAR();
    }
}
__device__ __forceinline__ void row_to_regs(const Ctx& c, float v, float (&out)[16]) {
    LAS float* wsf = (LAS float*)(c.shm + L_WS) + c.wid * 64;
    if (c.hi == 0) wsf[c.r32] = v;
    LDS_WAIT();
#pragma unroll
    for (int r = 0; r < 16; ++r) out[r] = wsf[crow(r, c.hi)];
    LDS_WAIT();
}
__device__ __forceinline__ float total_l(float l) { auto rr = __builtin_amdgcn_permlane32_swap(__float_as_uint(l), __float_as_uint(l), false, false); return __uint_as_float(rr[0]) + __uint_as_float(rr[1]); }
__device__ __forceinline__ void store_o(const Ctx& c, const f32x16 (&o)[2], bf16* orow0) {
    LAS bf16* stg = (LAS bf16*)(c.shm + L_OST + c.wid * 8192);
#pragma unroll
    for (int r = 0; r < 16; ++r) { const int orow = crow(r, c.hi);
#pragma unroll
        for (int d0 = 0; d0 < 2; ++d0) stg[orow * 64 + d0 * 32 + c.r32] = (bf16)f2bf(o[d0][r]); }
    LDS_WAIT();
#pragma unroll
    for (int i = 0; i < 4; ++i) { const int row = i * 8 + (c.lane >> 3), ch = c.lane & 7; const u32x4 v = *(const LAS u32x4*)(stg + row * 64 + ch * 8); *(u32x4*)(orow0 + (size_t)row * 1024 + ch * 8) = v; }
    LDS_WAIT();
}

constexpr int L_KNP = L_TB + 16384, L_WSM = L_KNP + 512;
constexpr float FOX_MARGIN = 32.0f;
struct FoxPol {
    static constexpr bool TRACK = true;
    static constexpr bool LOWREG = false;
    int nt; int qpos; int hi; int lane; int wid; float cq; float qn; LAS const float* ckl; LAS const float* knp; LAS float* wsm;
    __device__ __forceinline__ int k0(int i) const { return 64 * (nt - 1 - i); }
    __device__ __forceinline__ void init(f32x16& c0, f32x16& c1, float m, int i) const {
        const float base = cq - m; LAS const float* p = ckl + 64 * (nt - 1 - i) + 4 * hi;
#pragma unroll
        for (int g = 0; g < 4; ++g) { const f32x4 a = *(LAS const f32x4*)(p + 8 * g), b = *(LAS const f32x4*)(p + 32 + 8 * g);
#pragma unroll
            for (int e = 0; e < 4; ++e) { c0[4 * g + e] = base - a[e]; c1[4 * g + e] = base - b[e]; } }
    }
    __device__ __forceinline__ void mask(f32x16& c0, f32x16& c1, int i) const {
        if (i < 4) { const int kb = 64 * (nt - 1 - i) + 4 * hi;
#pragma unroll
            for (int r = 0; r < 16; ++r) { const int kv = kb + (r & 3) + 8 * (r >> 2); if (kv > qpos) c0[r] = MASKV; if (kv + 32 > qpos) c1[r] = MASKV; } }
    }
    __device__ __forceinline__ void track(State& st, float rm, int i) const {
        st.mt = fmaxf(st.mt, st.m + rm);
        if (i & 1) { float s = st.mt - cq - qn * knp[nt - 1 - i] - 0.05f;
#pragma unroll
            for (int o = 1; o < 64; o <<= 1) s = fminf(s, __shfl_xor(s, o));
            if (lane == 0) wsm[wid] = s; }
    }
};
template <bool PRE = false, class Pol>
__device__ __forceinline__ void run_branch_fox(const Ctx& c, Pol& pol, const bf16* Kg, const bf16* Vg, int pitch, const bf16x8 (&qr)[4], State& st) {
    const int NT = pol.nt; int NTe = NT;
    LAS float* wsf = (LAS float*)(c.shm + L_WS) + c.wid * 64;
    if (!PRE) issue_first(c, pol, Kg, Vg, pitch);
    FA_BAR();
    f32x16 a0, a1, b0, b1;
    pol.init(a0, a1, st.m, 0); qk_tile(c, 0, qr, a0, a1);
    FA_BAR();
    int t = 0;
    for (;; t += 2) {
        if (t >= 2 && t < NTe) {
            float smin = pol.wsm[0];
#pragma unroll
            for (int w = 1; w < NWAVES; ++w) smin = fminf(smin, pol.wsm[w]);
            const float lim = smin - FOX_MARGIN; const int T0 = NT - 1 - t;
            int first = 3;
            if (T0 >= 2 && -pol.ckl[64 * (T0 - 2) + 63] < lim) first = 2;
            if (T0 >= 1 && -pol.ckl[64 * (T0 - 1) + 63] < lim) first = 1;
            if (-pol.ckl[64 * T0 + 63] < lim) first = 0;
            first = __builtin_amdgcn_readfirstlane(first);
            if (first < 3 && t + first < NTe) NTe = t + first;
        }
        if (!(t + 2 < NTe)) break;
        dma_k(c, Kg, pitch, pol.k0(t + 2), 0); dma_v(c, Vg, pitch, pol.k0(t + 1), 1);
        fa_step<true, true>(c, pol, qr, st, a0, a1, b0, b1, t, 0, wsf);
        FA_BAR();
        if (t + 3 < NTe) dma_k(c, Kg, pitch, pol.k0(t + 3), 1);
        dma_v(c, Vg, pitch, pol.k0(t + 2), 0);
        fa_step<true, true>(c, pol, qr, st, b0, b1, a0, a1, t + 1, 1, wsf);
        FA_BAR();
    }
    if (t + 1 < NTe) {
        dma_v(c, Vg, pitch, pol.k0(t + 1), 1);
        fa_step<true, true>(c, pol, qr, st, a0, a1, b0, b1, t, 0, wsf);
        FA_BAR();
        fa_step<false, true>(c, pol, qr, st, b0, b1, a0, a1, t + 1, 1, wsf);
        FA_BAR();
    } else if (t < NTe) {
        fa_step<false, true>(c, pol, qr, st, a0, a1, b0, b1, t, 0, wsf);
        FA_BAR();
    }
}
__device__ __forceinline__ void fox_unit(Frame& F, int b, int h, int qb) {
    Ctx c; { int l_ = F.lane; asm volatile("" : "+v"(l_)); c.lane = l_; } c.r32 = c.lane & 31; c.hi = c.lane >> 5; c.wid = F.wave; c.shm = F.lds + RING_OFF;
    const bf16* P = (const bf16*)(F.ws + WS_P); const float* CK = (const float*)(F.ws + WS_CK) + (size_t)(b * 16 + h) * 4096; bf16* O = (bf16*)(F.ws + WS_O);
    const float* KNT = (const float*)(F.ws + WS_KNT) + (b * 16 + h) * 64;
    const int q0 = qb * 256; const size_t rowbase = (size_t)b * 4096;
    LAS float* ckl = (LAS float*)(c.shm + L_CK); LAS float* knp = (LAS float*)(c.shm + L_KNP); LAS float* wsm = (LAS float*)(c.shm + L_WSM);
    const int tid = c.wid * 64 + c.lane;
    FoxPol pol; pol.nt = (q0 + 256) / 64;
    issue_first(c, pol, P + rowbase * N1 + C_FK + h * 64, P + rowbase * N1 + C_FV + h * 64, N1);
    dma_copy(c, CK, L_CK, qb + 1);
    if (tid < 64) { float v = KNT[tid];
#pragma unroll
        for (int o = 1; o < 64; o <<= 1) { const float u = __shfl_up(v, o); if (c.lane >= o) v = fmaxf(v, u); }
        knp[tid] = v; }
    const int qpos = q0 + c.wid * 32 + c.r32;
    bf16x8 qr[4]; load_q(qr, P + (rowbase + qpos) * N1 + C_FQ + h * 64, c.hi);
    float ss = 0.f;
#pragma unroll
    for (int d0 = 0; d0 < 4; ++d0)
#pragma unroll
        for (int e = 0; e < 8; ++e) { const float v = bf2f((bf16)qr[d0][e]); ss += v * v; }
    { auto rr = __builtin_amdgcn_permlane32_swap(__float_as_uint(ss), __float_as_uint(ss), false, false); ss = __uint_as_float(rr[0]) + __uint_as_float(rr[1]); }
    pol.qpos = qpos; pol.hi = c.hi; pol.lane = c.lane; pol.wid = c.wid; pol.cq = CK[qpos]; pol.qn = sqrtf(ss) * 1.001f; pol.ckl = ckl; pol.knp = knp; pol.wsm = wsm;
    State st; reset(st);
    __syncthreads();
    run_branch_fox<true>(c, pol, P + rowbase * N1 + C_FK + h * 64, P + rowbase * N1 + C_FV + h * 64, N1, qr, st);
    float rl[16]; row_to_regs(c, 1.0f / total_l(st.l), rl);
#pragma unroll
    for (int r = 0; r < 16; ++r) { st.o[0][r] *= rl[r]; st.o[1][r] *= rl[r]; }
    store_o(c, st.o, O + (rowbase + q0 + c.wid * 32) * 1024 + h * 64);
    __syncthreads();
}
__device__ __forceinline__ void ph_fox_flash(Frame& F) {
    if (F.wave >= 4) __builtin_amdgcn_s_setprio(1);
    unsigned* ctr = (unsigned*)(F.ctl + CW_QFOX); LAS int* nxt = (LAS int*)(F.lds + RING_OFF + L_WSM + 64);
#pragma unroll 1
    for (;;) {
        if (F.tid == 0) *nxt = (int)__hip_atomic_fetch_add(ctr, 1u, __ATOMIC_RELAXED, __HIP_MEMORY_SCOPE_AGENT);
        __syncthreads();
        const int u = __builtin_amdgcn_readfirstlane(*nxt);
        if (u >= 2048) break;
        const int bh = u & 127; fox_unit(F, bh >> 4, bh & 15, 15 - (u >> 7));
    }
    __builtin_amdgcn_s_setprio(0);
}
__device__ __forceinline__ void ph_fox_knorm(Frame& F) {
    const bf16* P = (const bf16*)(F.ws + WS_P); float* KNT = (float*)(F.ws + WS_KNT);
    const int kw = (F.G > 128) ? (F.vcu - 128) * NWAVES + F.wave : F.gw, NKW = (F.G > 128) ? (F.G - 128) * NWAVES : F.NGW;
    if (kw < 0) return;
    for (int it0 = kw; it0 < 128 * 64; it0 += 2 * NKW) {
        v4u w[2][8];
#pragma unroll
        for (int q = 0; q < 2; ++q) { const int it = (it0 + q * NKW < 128 * 64) ? it0 + q * NKW : it0; const int T = it & 63, bh = it >> 6, b = bh >> 4, h = bh & 15;
            const bf16* kp = P + ((size_t)b * 4096 + T * 64 + (F.lane >> 3)) * N1 + C_FK + h * 64 + (F.lane & 7) * 8;
#pragma unroll
            for (int j = 0; j < 8; ++j) w[q][j] = *(const v4u*)(kp + (size_t)(8 * j) * N1); }
        asm volatile("" ::: "memory");
#pragma unroll
        for (int q = 0; q < 2; ++q) { const int it = it0 + q * NKW; if (it < 128 * 64) { float mx = 0.f;
#pragma unroll
            for (int j = 0; j < 8; ++j) { const v4u x = w[q][j];
                float ss = bflo(x.x) * bflo(x.x) + bfhi(x.x) * bfhi(x.x) + bflo(x.y) * bflo(x.y) + bfhi(x.y) * bfhi(x.y) + bflo(x.z) * bflo(x.z) + bfhi(x.z) * bfhi(x.z) + bflo(x.w) * bflo(x.w) + bfhi(x.w) * bfhi(x.w);
                ss += __shfl_xor(ss, 1); ss += __shfl_xor(ss, 2); ss += __shfl_xor(ss, 4); mx = fmaxf(mx, ss); }
            mx = wave_max(mx); if (F.lane == 0) KNT[it] = sqrtf(mx) * 1.0001f; } }
    }
}
__device__ __forceinline__ void stage_table(const Frame& F, LAS float* rt, const float* tbh) {
    for (int j = F.tid; j < TB_STRIDE; j += NWAVES * 64) rt[j] = (j < 1024) ? tbh[1023 - j] : 0.f;
}
__device__ __forceinline__ void init_table(f32x16& c0, f32x16& c1, float base, LAS const float* p) {
#pragma unroll
    for (int r = 0; r < 16; ++r) { const int ko = (r & 3) + 8 * (r >> 2); c0[r] = base + p[ko]; c1[r] = base + p[32 + ko]; }
}
__device__ __forceinline__ void init_const(f32x16& c0, f32x16& c1, float v) {
#pragma unroll
    for (int r = 0; r < 16; ++r) { c0[r] = v; c1[r] = v; }
}
__device__ __forceinline__ void mask_causal(f32x16& c0, f32x16& c1, int kb  , int qpos) {
#pragma unroll
    for (int r = 0; r < 16; ++r) { const int kv = kb + (r & 3) + 8 * (r >> 2); if (kv > qpos) c0[r] = MASKV; if (kv + 32 > qpos) c1[r] = MASKV; }
}
struct MobaPol {
    static constexpr bool TRACK = false;
    static constexpr bool LOWREG = false;
    int nt, blk, qpos, q0w, hi; unsigned msel; LAS const float* rt; float c31;
    __device__ __forceinline__ int k0(int i) const { return 64 * i; }
    __device__ __forceinline__ void init(f32x16& c0, f32x16& c1, float m, int i) const {
        const int n = i >> 2; const bool sel = (n == blk) || ((msel >> n) & 1u); const float base = sel ? -m : MASKV;
        if (q0w - 64 * i - 63 < 790) init_table(c0, c1, base, rt + (1023 - qpos + 64 * i + 4 * hi));
        else init_const(c0, c1, base + c31);
    }
    __device__ __forceinline__ void mask(f32x16& c0, f32x16& c1, int i) const { if (i >= nt - 4) mask_causal(c0, c1, 64 * i + 4 * hi, qpos); }
};
__device__ __forceinline__ void moba_unit(Frame& F, int b, int h, int blk) {
    Ctx c; { int l_ = F.lane; asm volatile("" : "+v"(l_)); c.lane = l_; } c.r32 = c.lane & 31; c.hi = c.lane >> 5; c.wid = F.wave; c.shm = F.lds + RING_OFF;
    const bf16* P = (const bf16*)(F.ws + WS_P); const float* TB = (const float*)(F.ws + WS_TB) + h * 1024; bf16* O = (bf16*)(F.ws + WS_O);
    const int q0 = blk * 256; const size_t rowbase = (size_t)b * 4096;
    LAS float* rt = (LAS float*)(c.shm + L_TB);
    MobaPol pol; pol.nt = 4 * (blk + 1);
    issue_first(c, pol, P + rowbase * N0 + C_MK + h * 64, P + rowbase * N0 + C_MV + h * 64, N0);
    dma_copy(c, (const float*)(F.ws + WS_RT) + h * TB_STRIDE, L_TB, 5);
    const int qpos = q0 + c.wid * 32 + c.r32;
    bf16x8 qr[4]; load_q(qr, P + (rowbase + qpos) * N0 + C_MQ + h * 64, c.hi);
    unsigned msel = 0u;
    if (blk > 0) {
        const float* KM = (const float*)(F.ws + WS_KMEAN) + (size_t)((b * 8 + h) * 16) * 64;
        f32x16 rs = {};
#pragma unroll
        for (int d0 = 0; d0 < 4; ++d0) { bf16x8 ah = {}, al = {};
            if (c.r32 < 16) { const float* kp = KM + c.r32 * 64 + d0 * 16 + c.hi * 8; const f32x4 x0 = *(const f32x4*)kp, x1 = *(const f32x4*)(kp + 4);
#pragma unroll
                for (int e = 0; e < 4; ++e) { const unsigned h0 = f2bf(x0[e]), h1 = f2bf(x1[e]); ah[e] = (short)h0; ah[4 + e] = (short)h1;
                    al[e] = (short)f2bf(x0[e] - bf2f((bf16)h0)); al[4 + e] = (short)f2bf(x1[e] - bf2f((bf16)h1)); } }
            rs = __builtin_amdgcn_mfma_f32_32x32x16_bf16(ah, qr[d0], rs, 0, 0, 0); rs = __builtin_amdgcn_mfma_f32_32x32x16_bf16(al, qr[d0], rs, 0, 0, 0); }
        float own[8], oth[8];
#pragma unroll
        for (int i = 0; i < 8; ++i) { own[i] = rs[i]; auto rr = __builtin_amdgcn_permlane32_swap(__float_as_uint(own[i]), __float_as_uint(own[i]), false, false); oth[i] = __uint_as_float(c.hi ? rr[0] : rr[1]); }
#pragma unroll
        for (int r = 0; r < 3; ++r) { float best = -3.0e38f; int bi = 99;
#pragma unroll
            for (int i = 0; i < 8; ++i) { const int no = (i & 3) + 8 * (i >> 2) + 4 * c.hi, np = (i & 3) + 8 * (i >> 2) + 4 * (1 - c.hi);
                if (no < blk && !((msel >> no) & 1u) && (own[i] > best || (own[i] == best && no < bi))) { best = own[i]; bi = no; }
                if (np < blk && !((msel >> np) & 1u) && (oth[i] > best || (oth[i] == best && np < bi))) { best = oth[i]; bi = np; } }
            if (bi < 16) msel |= 1u << bi; }
    }
    pol.blk = blk; pol.qpos = qpos; pol.q0w = q0 + c.wid * 32; pol.hi = c.hi; pol.msel = msel; pol.rt = rt; pol.c31 = TB[1023];
    State st; reset(st);
    __syncthreads();
    run_branch<true>(c, pol, P + rowbase * N0 + C_MK + h * 64, P + rowbase * N0 + C_MV + h * 64, N0, qr, st);
    float rl[16]; row_to_regs(c, 1.0f / total_l(st.l), rl);
#pragma unroll
    for (int r = 0; r < 16; ++r) { st.o[0][r] *= rl[r]; st.o[1][r] *= rl[r]; }
    store_o(c, st.o, O + (rowbase + q0 + c.wid * 32) * 1024 + h * 64);
    __syncthreads();
}
__device__ __forceinline__ void ph_moba_flash(Frame& F) {
    if (F.wave >= 4) __builtin_amdgcn_s_setprio(1);
    unsigned* ctr = (unsigned*)(F.ctl + CW_QMOBA); LAS int* nxt = (LAS int*)(F.lds + RING_OFF + L_WS + NWAVES * 64 * 4 - 16);
#pragma unroll 1
    for (;;) {
        if (F.tid == 0) *nxt = (int)__hip_atomic_fetch_add(ctr, 1u, __ATOMIC_RELAXED, __HIP_MEMORY_SCOPE_AGENT);
        __syncthreads();
        const int u = __builtin_amdgcn_readfirstlane(*nxt);
        if (u >= 1024 + LATE_CHUNKS) break;
        int mu = u - LATE_CHUNKS;
        if (u < 6 * LATE_CHUNKS) { if (u % 6 == 5) { late_weight_chunk(F, u / 6); __syncthreads(); continue; } mu = u - u / 6; }
        const int bh = mu & 63; moba_unit(F, bh >> 3, bh & 7, 15 - (mu >> 6));
    }
    __builtin_amdgcn_s_setprio(0);
}
__device__ __forceinline__ void cmp2_tile(Frame& F, int pm) {
    asm volatile("s_waitcnt vmcnt(0)" ::: "memory"); __syncthreads();
    const int lane = F.lane, r32 = lane & 31, hi = lane >> 5, w8 = F.wave, w = pm >> 4;
    const bf16* A = (const bf16*)(F.ws + WS_HID) + (size_t)(pm * 256 + 32 * w8 + r32) * 256 + hi * 8;
#pragma unroll
    for (int cb = 0; cb < 2; ++cb) {
        const bf16* W2 = (const bf16*)(F.ws + WS_W2T) + (size_t)(w * 64 + 32 * cb + r32) * 256 + hi * 8; f32x16 o = {};
#pragma unroll
        for (int ks = 0; ks < 16; ++ks) { const bf16x8 av = *(const bf16x8*)(A + ks * 16), bv = *(const bf16x8*)(W2 + ks * 16); o = __builtin_amdgcn_mfma_f32_32x32x16_bf16(av, bv, o, 0, 0, 0); }
        bf16* KV = (bf16*)(F.ws + WS_KVCMP) + ((size_t)pm * 256 + 32 * w8) * 64 + 32 * cb + r32;
#pragma unroll
        for (int r = 0; r < 16; ++r) KV[(size_t)((r & 3) + 8 * (r >> 2) + 4 * hi) * 64] = (bf16)f2bf(o[r]);
    }
}
struct SlcPol {
    static constexpr bool TRACK = false;
    static constexpr bool LOWREG = true;
    int nt, qpos, q0w, hi; unsigned long long ssel; LAS const float* rt; float c31;
    __device__ __forceinline__ int k0(int i) const { return 64 * i; }
    __device__ __forceinline__ void init(f32x16& c0, f32x16& c1, float m, int i) const {
        const bool sel = (ssel >> i) & 1ull; const float base = sel ? -m : MASKV;
        if (q0w - 64 * i - 63 < 790) init_table(c0, c1, base, rt + (1023 - qpos + 64 * i + 4 * hi));
        else init_const(c0, c1, base + c31);
    }
    __device__ __forceinline__ void mask(f32x16& c0, f32x16& c1, int i) const { if (i == nt - 1) mask_causal(c0, c1, 64 * i + 4 * hi, qpos); }
};
struct WinPol {
    static constexpr bool TRACK = false;
    static constexpr bool LOWREG = true;
    int nt, t0, sb, qpos, hi; LAS const float* rt;
    __device__ __forceinline__ int k0(int i) const { return 64 * (t0 + i); }
    __device__ __forceinline__ void init(f32x16& c0, f32x16& c1, float m, int i) const { init_table(c0, c1, -m, rt + (1023 - qpos + 64 * (t0 + i) + 4 * hi)); }
    __device__ __forceinline__ void mask(f32x16& c0, f32x16& c1, int i) const {
        const int tb = t0 + i, kb = 64 * tb + 4 * hi;
        if (tb == sb) mask_causal(c0, c1, kb, qpos);
        if (tb == sb - 8) {
#pragma unroll
            for (int r = 0; r < 16; ++r) { const int kv = kb + (r & 3) + 8 * (r >> 2); if (qpos - kv > 511) c0[r] = MASKV; if (qpos - kv - 32 > 511) c1[r] = MASKV; } }
    }
};
struct CmpPol {
    static constexpr bool TRACK = false;
    static constexpr bool LOWREG = true;
    int nt, qpos, hi; LAS const float* rt;
    __device__ __forceinline__ int k0(int i) const { return 64 * i; }
    __device__ __forceinline__ void init(f32x16& c0, f32x16& c1, float m, int i) const {
        const int ib = 1054 - qpos + 16 * (64 * i + 4 * hi);
#pragma unroll
        for (int r = 0; r < 16; ++r) { const int ko = 16 * ((r & 3) + 8 * (r >> 2)); const int i0 = ib + ko, i1 = ib + ko + 512;
            c0[r] = rt[i0 > 0 ? i0 : 0] - m; c1[r] = rt[i1 > 0 ? i1 : 0] - m; if ((r & 3) == 3) asm volatile("" ::: "memory"); }
    }
    __device__ __forceinline__ void mask(f32x16& c0, f32x16& c1, int i) const {
        const int nb = 64 * i + 4 * hi;
#pragma unroll
        for (int r = 0; r < 16; ++r) { const int n = nb + (r & 3) + 8 * (r >> 2); if (16 * n + 31 > qpos) c0[r] = MASKV; if (16 * (n + 32) + 31 > qpos) c1[r] = MASKV; }
    }
};
__device__ __forceinline__ void nsa_unit(Frame& F, int b, int g, int qblk) {
    Ctx c; { int l_ = F.lane; asm volatile("" : "+v"(l_)); c.lane = l_; } c.r32 = c.lane & 31; c.hi = c.lane >> 5; c.wid = F.wave; c.shm = F.lds + RING_OFF;
    const bf16* P = (const bf16*)(F.ws + WS_P); const float* TB = (const float*)(F.ws + WS_TB); bf16* O = (bf16*)(F.ws + WS_O);
    const bf16* KVC = (const bf16*)(F.ws + WS_KVCMP); const float* GZ = (const float*)(F.ws + WS_GZ);
    const int q0 = qblk * 64, sb = qblk; const size_t rowbase = (size_t)b * 4096;
    const int j = c.wid >> 1, sub = c.wid & 1, hn = 4 * g + j;
    const bf16* Kc = KVC + (size_t)((0 * 16 + b * 2 + g) * 256) * 64; const bf16* Vc = KVC + (size_t)((1 * 16 + b * 2 + g) * 256) * 64;
    CmpPol cpol; cpol.nt = (4 * qblk + 3 + 63) >> 6;
    issue_first(c, cpol, Kc, Vc, 64);
    dma_copy(c, (const float*)(F.ws + WS_RT) + (8 + 4 * g) * TB_STRIDE, L_TB, 20);
    LAS const float* rt = (LAS const float*)(c.shm + L_TB) + j * TB_STRIDE;
    LAS unsigned* impfx = (LAS unsigned*)(c.shm + L_IMP);
    LAS unsigned long long* sel64 = (LAS unsigned long long*)(c.shm + L_SEL);
    for (int i = F.tid; i < 2 * 65 * 32; i += NWAVES * 64) impfx[i] = 0u;
    const int qpos = q0 + sub * 32 + c.r32; const size_t row = rowbase + qpos;
    bf16x8 qr[4]; load_q(qr, P + row * N0 + C_NQ + hn * 64, c.hi);
    const float g0 = 1.f / (1.f + __expf(-GZ[row * 32 + hn * 3 + 0])), g1 = 1.f / (1.f + __expf(-GZ[row * 32 + hn * 3 + 1])), g2 = 1.f / (1.f + __expf(-GZ[row * 32 + hn * 3 + 2]));
    LAS float* park = (LAS float*)(c.shm + L_OST + c.wid * 8192);
    State st; reset(st);
    __syncthreads();
    {   CmpPol& pol = cpol; pol.qpos = qpos; pol.hi = c.hi; pol.rt = rt;
        run_branch<true>(c, pol, Kc, Vc, 64, qr, st);
        const float lt = total_l(st.l); const float inv = (lt > 0.f) ? 1.0f / lt : 0.f;
        { float rl[16]; row_to_regs(c, g0 * inv, rl);
#pragma unroll
          for (int r = 0; r < 16; ++r) { park[r * 128 + c.lane] = st.o[0][r] * rl[r]; park[r * 128 + 64 + c.lane] = st.o[1][r] * rl[r]; } }
        const float sc = inv * 16777216.0f;
        dma_kv(c, Kc, Vc, 64, 0, 0); FA_BAR();
        for (int i = 0; i < pol.nt; ++i) { const int slot = i & 1;
            if (i + 1 < pol.nt) dma_kv(c, Kc, Vc, 64, 64 * (i + 1), slot ^ 1);
            f32x16 c0, c1; pol.init(c0, c1, st.m, i);
            qk_tile(c, slot, qr, c0, c1);
            pol.mask(c0, c1, i);
            LAS unsigned* ib = impfx + (sub * 65 + 16 * i + c.hi) * 32 + c.r32;
#pragma unroll
            for (int gq = 0; gq < 4; ++gq) {
                const float a0 = __builtin_amdgcn_exp2f(c0[4 * gq]) * sc, a1 = __builtin_amdgcn_exp2f(c0[4 * gq + 1]) * sc, a2 = __builtin_amdgcn_exp2f(c0[4 * gq + 2]) * sc, a3 = __builtin_amdgcn_exp2f(c0[4 * gq + 3]) * sc;
                const float b0 = __builtin_amdgcn_exp2f(c1[4 * gq]) * sc, b1 = __builtin_amdgcn_exp2f(c1[4 * gq + 1]) * sc, b2 = __builtin_amdgcn_exp2f(c1[4 * gq + 2]) * sc, b3 = __builtin_amdgcn_exp2f(c1[4 * gq + 3]) * sc;
                const unsigned ua3 = (unsigned)(a3 + 0.5f), ub3 = (unsigned)(b3 + 0.5f);
                const unsigned ua = (unsigned)(a0 + 0.5f) + (unsigned)(a1 + 0.5f) + (unsigned)(a2 + 0.5f) + ua3, ub = (unsigned)(b0 + 0.5f) + (unsigned)(b1 + 0.5f) + (unsigned)(b2 + 0.5f) + ub3;
                __hip_atomic_fetch_add(ib + (2 * gq) * 32, ua, __ATOMIC_RELAXED, __HIP_MEMORY_SCOPE_WORKGROUP); __hip_atomic_fetch_add(ib + (2 * gq + 1) * 32, ua3, __ATOMIC_RELAXED, __HIP_MEMORY_SCOPE_WORKGROUP);
                __hip_atomic_fetch_add(ib + (8 + 2 * gq) * 32, ub, __ATOMIC_RELAXED, __HIP_MEMORY_SCOPE_WORKGROUP); __hip_atomic_fetch_add(ib + (8 + 2 * gq + 1) * 32, ub3, __ATOMIC_RELAXED, __HIP_MEMORY_SCOPE_WORKGROUP);
            }
            FA_BAR();
        }
    }
    SlcPol spol; spol.nt = sb + 1;
    issue_first(c, spol, P + rowbase * N0 + C_KSL + g * 64, P + rowbase * N0 + C_VSL + g * 64, N0);
    for (int k = 0; k < 8; ++k) { const int qq = c.wid * 8 + k; const int m = c.lane;
        const unsigned v = impfx[((qq >> 5) * 65 + m) * 32 + (qq & 31)];
        const bool valid = m <= sb, forced = (m == 0) || (m == sb) || (m == sb - 1);
        const unsigned key = (valid && !forced) ? v + 1u : 0u;
        const int nforced = (sb >= 2) ? 3 : sb + 1; const int R = 16 - nforced;
        bool pick = key > 0u;
        if (__popcll(__ballot(key > 0u)) > R) {
            unsigned T = 0u;
#pragma unroll 1
            for (int bit = 27; bit >= 0; --bit) { const unsigned cand = T | (1u << bit); if (__popcll(__ballot(key >= cand)) >= R) T = cand; }
            const int G = __popcll(__ballot(key > T)); const unsigned long long E = __ballot(key == T);
            const int before = __popcll(E & ((1ull << m) - 1ull));
            pick = (key > T) || (key == T && before < R - G);
        }
        const unsigned long long msk = __ballot(valid && (forced || pick));
        if (c.lane == 0) sel64[qq] = msk; }
    LDS_WAIT();
    __syncthreads();
    reset(st);
    { SlcPol& pol = spol; pol.qpos = qpos; pol.q0w = q0 + sub * 32; pol.hi = c.hi; pol.ssel = sel64[sub * 32 + c.r32]; pol.rt = rt; pol.c31 = TB[(8 + hn) * 1024 + 1023];
      run_branch<true>(c, pol, P + rowbase * N0 + C_KSL + g * 64, P + rowbase * N0 + C_VSL + g * 64, N0, qr, st); }
    WinPol wpol; wpol.t0 = (sb >= 8) ? sb - 8 : 0; wpol.nt = sb - wpol.t0 + 1;
    issue_first(c, wpol, P + rowbase * N0 + C_KWN + g * 64, P + rowbase * N0 + C_VWN + g * 64, N0);
    { float rl[16]; row_to_regs(c, g1 / total_l(st.l), rl);
#pragma unroll
      for (int r = 0; r < 16; ++r) { park[r * 128 + c.lane] += st.o[0][r] * rl[r]; park[r * 128 + 64 + c.lane] += st.o[1][r] * rl[r]; } }
    reset(st);
    { WinPol& pol = wpol; pol.sb = sb; pol.qpos = qpos; pol.hi = c.hi; pol.rt = rt;
      run_branch<true>(c, pol, P + rowbase * N0 + C_KWN + g * 64, P + rowbase * N0 + C_VWN + g * 64, N0, qr, st); }
    { float rl[16]; row_to_regs(c, g2 / total_l(st.l), rl);
#pragma unroll
      for (int r = 0; r < 16; ++r) { st.o[0][r] = st.o[0][r] * rl[r] + park[r * 128 + c.lane]; st.o[1][r] = st.o[1][r] * rl[r] + park[r * 128 + 64 + c.lane]; } }
    LDS_WAIT();
    store_o(c, st.o, O + (rowbase + q0 + sub * 32) * 1024 + (8 + hn) * 64);
    __syncthreads();
}
__device__ __forceinline__ void ph_nsa_flash(Frame& F) {
    if (F.wave >= 4) __builtin_amdgcn_s_setprio(1);
    unsigned* ctr = (unsigned*)(F.ctl + CW_QNSA); LAS int* nxt = (LAS int*)(F.lds + RING_OFF + L_WS + NWAVES * 64 * 4 - 16);
#pragma unroll 1
    for (;;) {
        if (F.tid == 0) *nxt = (int)__hip_atomic_fetch_add(ctr, 1u, __ATOMIC_RELAXED, __HIP_MEMORY_SCOPE_AGENT);
        __syncthreads();
        const int u = __builtin_amdgcn_readfirstlane(*nxt);
        if (u >= 1024) break;
        const int bg = u & 15; nsa_unit(F, bg >> 1, bg & 1, 63 - (u >> 4));
    }
    __builtin_amdgcn_s_setprio(0);
}
}
constexpr int N_PHASES = 16;
__global__ void __launch_bounds__(NWAVES * 64, 2) trunk_fwd(Args args) {
    extern __shared__ __attribute__((aligned(16))) unsigned char lds[];
    Frame F;
    F.lds = (LAS unsigned char*)lds;
    F.MISC = (volatile LAS unsigned*)(F.lds + MISC_OFF);
    F.tid = threadIdx.x; F.lane = F.tid & 63; F.wave = __builtin_amdgcn_readfirstlane(F.tid >> 6);
    F.G = gridDim.x; { const int bx = blockIdx.x; F.vcu = (F.G % 8 == 0) ? (bx % 8) * (F.G / 8) + bx / 8 : bx; }
    F.gw = F.vcu * NWAVES + F.wave; F.NGW = F.G * NWAVES;
    unsigned char* ws = args.ws; F.ws = ws;
    F.ctl = (gu32*)(ws + WS_CTL);
    for (int u = F.tid; u < (LDS_BYTES - LDSCTL_OFF) / 4; u += NWAVES * 64) ((LAS unsigned*)(F.lds + LDSCTL_OFF))[u] = 0u;
    __syncthreads();
    XcdBarrier bar = xcd_barrier_post((unsigned*)(F.ctl + CW_BAR), F.MISC + 8);
    const int lo = args.ph_lo, hi = args.ph_hi;
#define IN(k) (lo <= (k) && (k) < hi)
#define SEAM(k) do { if (IN(k) && IN((k) + 1)) xcd_barrier(bar); { int t_ = threadIdx.x; asm volatile("" : "+v"(t_)); F.tid = t_; F.lane = t_ & 63; } } while (0)
    float* SSQ = (float*)(ws + WS_SSQ);
    LAS float* RSTAB = (LAS float*)(F.lds + LDSCTL_OFF + 1024);
    bf16* XB = (bf16*)(ws + WS_XB); bf16* XL = (bf16*)(ws + WS_XL); bf16* P = (bf16*)(ws + WS_P); bf16* O = (bf16*)(ws + WS_O); bf16* A = (bf16*)(ws + WS_A);

    if (IN(0)) { p0_prologue(F, args); }
    SEAM(0);
    if (IN(1)) {
        pg8::Gemm g{XB, (const bf16*)(ws + WS_WIN0), M, N0G, 1024, 1024}; pg8::StaticOrder S; S.init(M, N0G, F.G, (int)blockIdx.x);
        pg8::EpiProj E{P, N0, SSQ, C2, (1u << 0) | (1u << 1) | (1u << 6) | (1u << 7), 8, (bf16*)(ws + WS_CMPIN), 11, (float*)(ws + WS_GZ), (float*)(ws + WS_KMEAN)};
        pg8::gemm_phase<pg8::EpiProj, pg8::StaticOrder, true, true>(F.lds + RING_OFF, g, S, E, SSQ, RSTAB);
    }
    SEAM(1);
    if (IN(2)) {
        if (F.vcu < 32) {
            pg8::Gemm g{(const bf16*)(ws + WS_CMPIN), (const bf16*)(ws + WS_WCMP), 8192, 512, 2048, 1024}; pg8::CmpOrder S{F.G, F.vcu};
            pg8::EpiSilu E{(bf16*)(ws + WS_HID), (const float*)(ws + WS_POSB)};
            pg8::gemm_phase<pg8::EpiSilu, pg8::CmpOrder, false, true>(F.lds + RING_OFF, g, S, E);
            fa::cmp2_tile(F, F.vcu);
            asm volatile("s_waitcnt vmcnt(0)" ::: "memory"); __syncthreads();
            if (F.tid == 0) { __builtin_amdgcn_fence(__ATOMIC_RELEASE, "agent"); asm volatile("s_waitcnt vmcnt(0)" ::: "memory");
                __hip_atomic_fetch_add((unsigned*)(F.ctl + CW_CMPDONE), 1u, __ATOMIC_RELAXED, __HIP_MEMORY_SCOPE_AGENT); }
            __syncthreads();
        }
        fa::ph_moba_flash(F);
    }
    if (IN(5)) {
        if (F.tid == 0) { unsigned sp = 0; const int want = (F.G >= 32) ? 32 : F.G;
            while ((int)__hip_atomic_load((unsigned*)(F.ctl + CW_CMPDONE), __ATOMIC_RELAXED, __HIP_MEMORY_SCOPE_AGENT) < want) { __builtin_amdgcn_s_sleep(2); if (++sp > (1u << 22)) break; }
            __builtin_amdgcn_fence(__ATOMIC_ACQUIRE, "agent"); asm volatile("s_waitcnt vmcnt(0)" ::: "memory"); }
        __syncthreads();
        fa::ph_nsa_flash(F);
    }
    SEAM(5);
    if (IN(6)) {
        pg8::Gemm g{O, (const bf16*)(ws + WS_WOUT0), M, 1024, 1024, 1024}; pg8::StaticOrder S; S.init(M, 1024, F.G, (int)blockIdx.x);
        pg8::EpiRes0 E{KIN(I_X), nullptr, XB, XL, SSQ + M};
        pg8::gemm_phase<pg8::EpiRes0, pg8::StaticOrder, true, true>(F.lds + RING_OFF, g, S, E);
    }
    SEAM(6);
    if (IN(7)) {
        pg8::Gemm g{XB, (const bf16*)(ws + WS_W1_0), M, FF, 1024, 1024}; pg8::StaticOrder S; S.init(M, FF, F.G, (int)blockIdx.x);
        pg8::EpiUp E{A, FF, SSQ + M};
        pg8::gemm_phase<pg8::EpiUp, pg8::StaticOrder, true, true>(F.lds + RING_OFF, g, S, E, SSQ + M, RSTAB);
    }
    SEAM(7);
    if (IN(8)) {
        pg8::Gemm g{A, (const bf16*)(ws + WS_W2_0), M, 1024, FF, FF}; pg8::StaticOrder S; S.init(M, 1024, F.G, (int)blockIdx.x);
        pg8::EpiRes1 E{nullptr, nullptr, XB, XL, SSQ + 2 * M};
        pg8::gemm_phase<pg8::EpiRes1, pg8::StaticOrder, true, true>(F.lds + RING_OFF, g, S, E);
    }
    SEAM(8);
    if (IN(9)) {
        pg8::Gemm g{XB, (const bf16*)(ws + WS_WIN1), M, N1, 1024, 1024}; pg8::StaticOrder S; S.init(M, N1, F.G, (int)blockIdx.x);
        pg8::EpiProj E{P, N1, SSQ + 2 * M, C2, 0xFu, 1000, (bf16*)(ws + WS_CMPIN), 1000, (float*)(ws + WS_GZ), nullptr};
        pg8::gemm_phase<pg8::EpiProj, pg8::StaticOrder, true, true>(F.lds + RING_OFF, g, S, E, SSQ + 2 * M, RSTAB);
        skinny_gemm(F, XB, (const bf16*)(ws + WS_WF1), SSQ + 2 * M, (float*)(ws + WS_GZ));
    }
    SEAM(9);
    if (IN(10)) { ph_fox_cum(F, args); fa::ph_fox_knorm(F); }
    SEAM(10);
    if (IN(11)) { fa::ph_fox_flash(F); }
    SEAM(11);
    if (IN(12)) {
        pg8::Gemm g{O, (const bf16*)(ws + WS_WOUT1), M, 1024, 1024, 1024}; pg8::StaticOrder S; S.init(M, 1024, F.G, (int)blockIdx.x);
        pg8::EpiRes1 E{nullptr, nullptr, XB, XL, SSQ + 3 * M};
        pg8::gemm_phase<pg8::EpiRes1, pg8::StaticOrder, true, true>(F.lds + RING_OFF, g, S, E);
    }
    SEAM(12);
    if (IN(13)) {
        pg8::Gemm g{XB, (const bf16*)(ws + WS_W1_1), M, FF, 1024, 1024}; pg8::StaticOrder S; S.init(M, FF, F.G, (int)blockIdx.x);
        pg8::EpiUp E{A, FF, SSQ + 3 * M};
        pg8::gemm_phase<pg8::EpiUp, pg8::StaticOrder, true, true>(F.lds + RING_OFF, g, S, E, SSQ + 3 * M, RSTAB);
    }
    SEAM(13);
    if (IN(14)) {
        pg8::Gemm g{A, (const bf16*)(ws + WS_W2_1), M, 1024, FF, FF}; pg8::StaticOrder S; S.init(M, 1024, F.G, (int)blockIdx.x);
        pg8::EpiRes2 E{nullptr, KOUT(), XB, XL, SSQ};
        pg8::gemm_phase<pg8::EpiRes2, pg8::StaticOrder, true, true>(F.lds + RING_OFF, g, S, E);
    }
    SEAM(14);
    if (IN(15)) { ph_final_norm(F, args); }
#undef IN
#undef SEAM
}

extern "C" void kernel_launch(void* const* d_in, const int* in_sizes, int n_in, void* d_out, int out_size, void* d_ws, size_t ws_size, hipStream_t stream) {
    static int grid = 0;
    if (grid == 0) {
        if (n_in != 18 || out_size != M * DM || ws_size < WS_END) { fprintf(stderr, "kernel_launch: unexpected shapes: n_in %d out %d ws %zu (need %zu)\n", n_in, out_size, ws_size, (size_t)WS_END); grid = -1; return; }
        int dev = 0, cus = 0, per_cu = 0;
        if (hipGetDevice(&dev) != hipSuccess || hipDeviceGetAttribute(&cus, hipDeviceAttributeMultiprocessorCount, dev) != hipSuccess) { grid = -1; return; }
        if (hipFuncSetAttribute((const void*)trunk_fwd, hipFuncAttributeMaxDynamicSharedMemorySize, LDS_BYTES) != hipSuccess) { fprintf(stderr, "kernel_launch: hipFuncSetAttribute failed\n"); grid = -1; return; }
        if (hipOccupancyMaxActiveBlocksPerMultiprocessor(&per_cu, (const void*)trunk_fwd, NWAVES * 64, LDS_BYTES) != hipSuccess || per_cu < 1) { fprintf(stderr, "kernel_launch: occupancy query says %d\n", per_cu); per_cu = 1; }
        (void)hipGetLastError();
        grid = cus;
    }
    if (grid < 0) return;
    (void)hipMemsetAsync((char*)d_ws + WS_CTL, 0, CTL_ZERO_BYTES, stream);
    Args a{};
    for (int i = 0; i < 18; ++i) a.in[i] = (const float*)d_in[i];
    a.out = (float*)d_out; a.ws = (unsigned char*)d_ws; a.ph_lo = 0; a.ph_hi = N_PHASES;
    hipLaunchKernelGGL(trunk_fwd, dim3(grid), dim3(NWAVES * 64), LDS_BYTES, stream, a);
}
```

```cpp
#include <hip/hip_runtime.h>
#include <cstdio>
#include <cstdint>
namespace pg8 {
#define PG8_LAS __attribute__((address_space(3)))
typedef unsigned short bf16_t;
typedef short bf16x8 __attribute__((ext_vector_type(8)));
typedef float f32x4 __attribute__((ext_vector_type(4)));
typedef unsigned u32x4 __attribute__((ext_vector_type(4)));
typedef unsigned u32x2 __attribute__((ext_vector_type(2)));
constexpr int BM = 256, BK = 64, HALF = 128, HTB = HALF * BK * 2  , STAGE_BYTES = 8 * HTB, NXCD = 8, WGM = 8;

__host__ __device__ __forceinline__ int lds_byte(int r, int c) { const int st = (r >> 4) * 2 + (c >> 5), rr = r & 15, cc = c & 31, ob = rr * 64 + cc * 2; return st * 1024 + (ob ^ (((ob >> 9) & 1) << 5)); }
__host__ __device__ __forceinline__ void stage_rc(int b, int& R, int& C) { const int st = b / 1024, sb = b % 1024, swz = sb ^ (((sb >> 9) & 1) << 5); R = (st >> 1) * 16 + swz / 64; C = (st & 1) * 32 + (swz % 64) / 2; }
__host__ __device__ __forceinline__ int perm32(int rho) { const int n = rho >> 4, i = rho & 15; return 8 * (i >> 2) + 4 * n + (i & 3); }

struct Unit { int pm, pn; };
struct Gemm { const bf16_t* A; const bf16_t* Bt; int M, N, K, lda; };

struct StaticOrder {
    int nM, nN, nwg, G, c;
    __host__ __device__ void init(int M, int N, int G_, int c_) { nM = M / BM; nN = N / BM; nwg = nM * nN; G = G_; c = c_; }
    __host__ __device__ bool next(int i, Unit& u) const {
        const long L = (long)i * G + c; if (L >= nwg) return false;
        int wgid = (int)L; { const int q = nwg / NXCD, r = nwg % NXCD, xcd = wgid % NXCD, off = wgid / NXCD; wgid = (xcd < r ? xcd * (q + 1) : r * (q + 1) + (xcd - r) * q) + off; }
        const int nig = WGM * nN, gid = wgid / nig, fm = gid * WGM, gsz = (nM - fm) < WGM ? (nM - fm) : WGM;
        u.pm = fm + ((wgid % nig) % gsz); u.pn = (wgid % nig) / gsz; return true;
    }
};
struct CmpOrder {
    int G, c;
    __device__ bool next(int i, Unit& u) const { const int L = i * G + c; if (L >= 32) return false; u.pm = L; u.pn = L >> 4; return true; }
};

__device__ __forceinline__ unsigned cvt_pk_bf16(float lo, float hi) { unsigned r; asm volatile("v_cvt_pk_bf16_f32 %0, %1, %2" : "=v"(r) : "v"(lo), "v"(hi)); return r; }

struct EpiProj {
    static constexpr bool PERM = true;
    bf16_t* O; int ldc; const float* ssq; float c2; unsigned qtiles; int cmp_tile; bf16_t* cmpin; int gate_tile; float* gz; float* km;
    __device__ __forceinline__ void operator()(const f32x4 (&acc)[2][2][4][2], const Unit& u, int wr, int wc, int fr, int fq, PG8_LAS const float* rs_tab) const {
        const int row0 = u.pm * BM + wr * 64 + fr; const int colt = u.pn * BM;
        const float sc = ((qtiles >> u.pn) & 1u) ? c2 : 1.f;
        const bool iscmp = (u.pn == cmp_tile);
        if (u.pn == gate_tile) {
            if (wc == 0) {
#pragma unroll
                for (int ai = 0; ai < 2; ++ai)
#pragma unroll
                    for (int m = 0; m < 4; ++m) { const int row = row0 + ai * HALF + m * 16; const float rs = rs_tab[row & 255];
                        *(f32x4*)(gz + (size_t)row * 32 + 8 * fq) = acc[ai][0][m][0] * rs; *(f32x4*)(gz + (size_t)row * 32 + 8 * fq + 4) = acc[ai][0][m][1] * rs; } }
            return;
        }
        const bool iskm = (km != nullptr) && (u.pn == 2 || u.pn == 3);
        float cs[2][2][4];
#pragma unroll
        for (int bj = 0; bj < 2; ++bj)
#pragma unroll
            for (int n = 0; n < 2; ++n)
#pragma unroll
                for (int e = 0; e < 4; ++e) cs[bj][n][e] = 0.f;
#pragma unroll
        for (int ai = 0; ai < 2; ++ai)
#pragma unroll
            for (int m = 0; m < 4; ++m) { const int row = row0 + ai * HALF + m * 16; const float rs = sc * rs_tab[row & 255];
#pragma unroll
                for (int bj = 0; bj < 2; ++bj) { const f32x4 v0 = acc[ai][bj][m][0] * rs, v1 = acc[ai][bj][m][1] * rs;
                    u32x4 w; w.x = cvt_pk_bf16(v0[0], v0[1]); w.y = cvt_pk_bf16(v0[2], v0[3]); w.z = cvt_pk_bf16(v1[0], v1[1]); w.w = cvt_pk_bf16(v1[2], v1[3]);
                    if (iskm) {
#pragma unroll
                        for (int e = 0; e < 4; ++e) { cs[bj][0][e] += v0[e]; cs[bj][1][e] += v1[e]; } }
                    bf16_t* dst;
                    if (iscmp) { const int b = row >> 12, s = row & 4095, g = wc >> 1, d0 = 32 * (wc & 1) + 8 * fq; dst = cmpin + ((size_t)((bj * 16 + b * 2 + g) * 4096 + s)) * 64 + d0; }
                    else dst = O + (size_t)row * ldc + colt + bj * HALF + wc * 32 + 8 * fq;
                    *(u32x4*)dst = w; } }
        if (iskm) {
            const int b = u.pm >> 4, nb = u.pm & 15;
#pragma unroll
            for (int bj = 0; bj < 2; ++bj)
#pragma unroll
                for (int n = 0; n < 2; ++n)
#pragma unroll
                    for (int e = 0; e < 4; ++e) { float s = cs[bj][n][e]; s += __shfl_xor(s, 1); s += __shfl_xor(s, 2); s += __shfl_xor(s, 4); s += __shfl_xor(s, 8);
                        if (fr == 0) { const int c = bj * HALF + wc * 32 + 8 * fq + 4 * n + e; const int h = (u.pn - 2) * 4 + (c >> 6), d = c & 63;
                            atomicAdd(km + ((b * 8 + h) * 16 + nb) * 64 + d, s * (1.0f / 256.0f)); } }
        }
    }
};
struct EpiUp {
    static constexpr bool PERM = true;
    bf16_t* O; int ldc; const float* ssq;
    __device__ __forceinline__ void operator()(const f32x4 (&acc)[2][2][4][2], const Unit& u, int wr, int wc, int fr, int fq, PG8_LAS const float* rs_tab) const {
        const int row0 = u.pm * BM + wr * 64 + fr; const int col0 = u.pn * BM + wc * 32 + 8 * fq;
#pragma unroll
        for (int ai = 0; ai < 2; ++ai)
#pragma unroll
            for (int m = 0; m < 4; ++m) { const int row = row0 + ai * HALF + m * 16; const float rs = rs_tab[row & 255];
#pragma unroll
                for (int bj = 0; bj < 2; ++bj) { f32x4 v0 = acc[ai][bj][m][0] * rs, v1 = acc[ai][bj][m][1] * rs;
#pragma unroll
                    for (int e = 0; e < 4; ++e) { const float a = fmaxf(v0[e], 0.f), b = fmaxf(v1[e], 0.f); v0[e] = a * a; v1[e] = b * b; }
                    u32x4 w; w.x = cvt_pk_bf16(v0[0], v0[1]); w.y = cvt_pk_bf16(v0[2], v0[3]); w.z = cvt_pk_bf16(v1[0], v1[1]); w.w = cvt_pk_bf16(v1[2], v1[3]);
                    *(u32x4*)(O + (size_t)row * ldc + col0 + bj * HALF) = w; } }
    }
};
struct EpiSilu {
    static constexpr bool PERM = true;
    bf16_t* O; const float* posb;
    __device__ __forceinline__ void operator()(const f32x4 (&acc)[2][2][4][2], const Unit& u, int wr, int wc, int fr, int fq, PG8_LAS const float* rs_tab) const {
        const int row0 = u.pm * BM + wr * 64 + fr; const int col0 = wc * 32 + 8 * fq;
#pragma unroll
        for (int bj = 0; bj < 2; ++bj) { const f32x4 b0 = *(const f32x4*)(posb + u.pn * 256 + col0 + bj * HALF), b1 = *(const f32x4*)(posb + u.pn * 256 + col0 + bj * HALF + 4);
#pragma unroll
            for (int ai = 0; ai < 2; ++ai)
#pragma unroll
                for (int m = 0; m < 4; ++m) { const int row = row0 + ai * HALF + m * 16; f32x4 v0 = acc[ai][bj][m][0] + b0, v1 = acc[ai][bj][m][1] + b1;
#pragma unroll
                    for (int e = 0; e < 4; ++e) { v0[e] = v0[e] / (1.f + __expf(-v0[e])); v1[e] = v1[e] / (1.f + __expf(-v1[e])); }
                    u32x4 w; w.x = cvt_pk_bf16(v0[0], v0[1]); w.y = cvt_pk_bf16(v0[2], v0[3]); w.z = cvt_pk_bf16(v1[0], v1[1]); w.w = cvt_pk_bf16(v1[2], v1[3]);
                    *(u32x4*)(O + (size_t)row * 256 + col0 + bj * HALF) = w; } }
    }
};
template <int MODE> struct EpiResT {
    static constexpr bool PERM = true;
    const float* base; float* out; bf16_t* xb; bf16_t* xl; float* ssq;
    __device__ __forceinline__ static void unpack8(const u32x4 a, const u32x4 b, f32x4& h0, f32x4& h1) {
        h0[0] = __builtin_bit_cast(float, a.x << 16) + __builtin_bit_cast(float, b.x << 16); h0[1] = __builtin_bit_cast(float, a.x & 0xffff0000u) + __builtin_bit_cast(float, b.x & 0xffff0000u);
        h0[2] = __builtin_bit_cast(float, a.y << 16) + __builtin_bit_cast(float, b.y << 16); h0[3] = __builtin_bit_cast(float, a.y & 0xffff0000u) + __builtin_bit_cast(float, b.y & 0xffff0000u);
        h1[0] = __builtin_bit_cast(float, a.z << 16) + __builtin_bit_cast(float, b.z << 16); h1[1] = __builtin_bit_cast(float, a.z & 0xffff0000u) + __builtin_bit_cast(float, b.z & 0xffff0000u);
        h1[2] = __builtin_bit_cast(float, a.w << 16) + __builtin_bit_cast(float, b.w << 16); h1[3] = __builtin_bit_cast(float, a.w & 0xffff0000u) + __builtin_bit_cast(float, b.w & 0xffff0000u);
    }
    __device__ __forceinline__ void operator()(const f32x4 (&acc)[2][2][4][2], const Unit& u, int wr, int wc, int fr, int fq, PG8_LAS const float* rs_tab) const {
        const int row0 = u.pm * BM + wr * 64 + fr, col0 = u.pn * BM + wc * 32 + 8 * fq;
#pragma unroll
        for (int ai = 0; ai < 2; ++ai) {
            u32x4 pre[4][2][2];
#pragma unroll
            for (int m = 0; m < 4; ++m) { const size_t off = (size_t)(row0 + ai * HALF + m * 16) * 1024 + col0;
#pragma unroll
                for (int bj = 0; bj < 2; ++bj) {
                    if (MODE == 0) { pre[m][bj][0] = *(const u32x4*)(base + off + bj * HALF); pre[m][bj][1] = *(const u32x4*)(base + off + bj * HALF + 4); }
                    else { pre[m][bj][0] = *(const u32x4*)(xb + off + bj * HALF); pre[m][bj][1] = *(const u32x4*)(xl + off + bj * HALF); } } }
            asm volatile("" ::: "memory");
#pragma unroll
            for (int m = 0; m < 4; ++m) { const int row = row0 + ai * HALF + m * 16; const size_t off = (size_t)row * 1024 + col0; float q = 0.f;
#pragma unroll
                for (int bj = 0; bj < 2; ++bj) { f32x4 h0, h1;
                    if (MODE == 0) { h0 = __builtin_bit_cast(f32x4, pre[m][bj][0]); h1 = __builtin_bit_cast(f32x4, pre[m][bj][1]); } else unpack8(pre[m][bj][0], pre[m][bj][1], h0, h1);
                    h0 = h0 + acc[ai][bj][m][0]; h1 = h1 + acc[ai][bj][m][1];
                    if (MODE == 2) { *(f32x4*)(out + off + bj * HALF) = h0; *(f32x4*)(out + off + bj * HALF + 4) = h1; }
                    else { q += ((h0[0] * h0[0] + h0[1] * h0[1]) + (h0[2] * h0[2] + h0[3] * h0[3])) + ((h1[0] * h1[0] + h1[1] * h1[1]) + (h1[2] * h1[2] + h1[3] * h1[3]));
                        u32x4 w; w.x = cvt_pk_bf16(h0[0], h0[1]); w.y = cvt_pk_bf16(h0[2], h0[3]); w.z = cvt_pk_bf16(h1[0], h1[1]); w.w = cvt_pk_bf16(h1[2], h1[3]);
                        u32x4 l; l.x = cvt_pk_bf16(h0[0] - __builtin_bit_cast(float, w.x << 16), h0[1] - __builtin_bit_cast(float, w.x & 0xffff0000u)); l.y = cvt_pk_bf16(h0[2] - __builtin_bit_cast(float, w.y << 16), h0[3] - __builtin_bit_cast(float, w.y & 0xffff0000u));
                        l.z = cvt_pk_bf16(h1[0] - __builtin_bit_cast(float, w.z << 16), h1[1] - __builtin_bit_cast(float, w.z & 0xffff0000u)); l.w = cvt_pk_bf16(h1[2] - __builtin_bit_cast(float, w.w << 16), h1[3] - __builtin_bit_cast(float, w.w & 0xffff0000u));
                        *(u32x4*)(xb + off + bj * HALF) = w; *(u32x4*)(xl + off + bj * HALF) = l; } }
                if (MODE != 2) { q += __shfl_xor(q, 16); q += __shfl_xor(q, 32);
                    if (fq == 0) atomicAdd(ssq + row, q); } }
            asm volatile("" ::: "memory");
        }
    }
};
typedef EpiResT<0> EpiRes0;
typedef EpiResT<1> EpiRes1;
typedef EpiResT<2> EpiRes2;

template <class Epi, class Sched, bool ALIGN_EPI = false, bool SP2 = false>
__device__ __forceinline__ void gemm_phase(PG8_LAS unsigned char* lds, const Gemm g, const Sched& S, const Epi& E, const float* rowss = nullptr, PG8_LAS float* aux = nullptr) {
    const int tid = threadIdx.x, wid = __builtin_amdgcn_readfirstlane(tid >> 6), lane = tid & 63, wr = wid >> 2, wc = wid & 3, fr = lane & 15, fq = lane >> 4;
    const int K = g.K, nt = K / BK, lda = g.lda;
    unsigned voffA[2], voffB[2];
#pragma unroll
    for (int i = 0; i < 2; ++i) { int R, C; stage_rc(tid * 16 + i * 8192, R, C); const int Rb = Epi::PERM ? ((R & ~31) + perm32(R & 31)) : R;
        voffA[i] = (unsigned)(R * lda + C) * 2u; voffB[i] = (unsigned)(Rb * K + C) * 2u; }
    const size_t kstep = (size_t)(BK * 2);
    const size_t hstepA = (size_t)HALF * lda * 2, hstepB = (size_t)HALF * K * 2;
    const size_t tstepA = 2 * hstepA, tstepB = 2 * hstepB;
    const unsigned ldsw = (unsigned)wid * 1024u;
    const int aoff = lds_byte(wr * 64 + fr, fq * 8), boff = lds_byte(wc * 32 + fr, fq * 8);
#define PG8_SA(b, h) (((b) * 2 + (h)) * HTB)
#define PG8_SB(b, h) ((4 + (b) * 2 + (h)) * HTB)
#define PG8_STAGE(bufoff, gbase, voff) do { _Pragma("unroll") for (int _i = 0; _i < 2; ++_i) \
        __builtin_amdgcn_global_load_lds((const unsigned*)((const char*)(gbase) + (voff)[_i]), (PG8_LAS unsigned*)(lds + (bufoff) + ldsw + _i * 8192), 16, 0, 0); } while (0)
#define PG8_LDA(dst, b, h) do { _Pragma("unroll") for (int m = 0; m < 4; ++m) _Pragma("unroll") for (int k = 0; k < 2; ++k) dst[m][k] = *(const PG8_LAS bf16x8*)(lds + PG8_SA(b, h) + aoff + m * 2048 + k * 1024); } while (0)
#define PG8_LDB(dst, b, h) do { _Pragma("unroll") for (int n = 0; n < 2; ++n) _Pragma("unroll") for (int k = 0; k < 2; ++k) dst[n][k] = *(const PG8_LAS bf16x8*)(lds + PG8_SB(b, h) + boff + n * 2048 + k * 1024); } while (0)
#define PG8_MMA(ai, bj, At, Bt) do { __builtin_amdgcn_s_setprio(1); _Pragma("unroll") for (int m = 0; m < 4; ++m) _Pragma("unroll") for (int n = 0; n < 2; ++n) _Pragma("unroll") for (int k = 0; k < 2; ++k) \
        acc[ai][bj][m][n] = __builtin_amdgcn_mfma_f32_16x16x32_bf16(Bt[n][k], At[m][k], acc[ai][bj][m][n], 0, 0, 0); __builtin_amdgcn_s_setprio(0); } while (0)
#define PG8_WAIT_V(n) asm volatile("s_waitcnt vmcnt(" #n ")" ::: "memory")
#define PG8_WAIT_L(n) asm volatile("s_waitcnt lgkmcnt(" #n ")" ::: "memory")
#define PG8_BAR __builtin_amdgcn_s_barrier()
#define PG8_SCHED __builtin_amdgcn_sched_barrier(0)
    Unit cur, nxt; int ui = 0;
    if (!S.next(0, cur)) return;
    f32x4 acc[2][2][4][2];
#pragma unroll
    for (int a = 0; a < 2; ++a)
#pragma unroll
        for (int b = 0; b < 2; ++b)
#pragma unroll
            for (int m = 0; m < 4; ++m)
#pragma unroll
                for (int n = 0; n < 2; ++n) acc[a][b][m][n] = (f32x4){0.f, 0.f, 0.f, 0.f};
    bf16x8 At[4][2], B0[2][2], B1[2][2];
    const char* cA = (const char*)g.A + (size_t)cur.pm * tstepA; const char* cB = (const char*)g.Bt + (size_t)cur.pn * tstepB;
    if (rowss && tid < 256) aux[tid] = __builtin_amdgcn_rsqf(rowss[cur.pm * BM + tid] * (1.0f / 1024.0f) + 1e-5f);
    if constexpr (SP2) {
        PG8_STAGE(PG8_SB(0, 0), cB, voffB); PG8_STAGE(PG8_SB(0, 1), cB + hstepB, voffB); PG8_STAGE(PG8_SA(0, 0), cA, voffA); PG8_STAGE(PG8_SA(0, 1), cA + hstepA, voffA);
        if (wr == 1) PG8_BAR;
        PG8_WAIT_V(2); PG8_BAR;
        PG8_STAGE(PG8_SB(1, 0), cB + kstep, voffB); PG8_STAGE(PG8_SA(1, 0), cA + kstep, voffA); PG8_STAGE(PG8_SB(1, 1), cB + hstepB + kstep, voffB);
        PG8_WAIT_V(6); PG8_BAR;
    } else {
        PG8_STAGE(PG8_SB(0, 0), cB, voffB); PG8_STAGE(PG8_SA(0, 0), cA, voffA); PG8_STAGE(PG8_SB(0, 1), cB + hstepB, voffB); PG8_STAGE(PG8_SA(0, 1), cA + hstepA, voffA);
        if (wr == 1) PG8_BAR;
        PG8_WAIT_V(4); PG8_BAR;
        PG8_STAGE(PG8_SB(1, 0), cB + kstep, voffB); PG8_STAGE(PG8_SA(1, 0), cA + kstep, voffA); PG8_STAGE(PG8_SB(1, 1), cB + hstepB + kstep, voffB);
        PG8_WAIT_V(6); PG8_BAR;
    }
    for (;;) {
        const bool has_next = S.next(ui + 1, nxt);
        const char* nA = has_next ? (const char*)g.A + (size_t)nxt.pm * tstepA : cA; const char* nB = has_next ? (const char*)g.Bt + (size_t)nxt.pn * tstepB : cB;
        for (int t = 0; t < nt; t += 2) {
            const bool last = (t == nt - 2);
            const char* a1 = cA + (size_t)(t + 1) * kstep;
            const char* a2 = last ? nA : cA + (size_t)(t + 2) * kstep; const char* b2 = last ? nB : cB + (size_t)(t + 2) * kstep;
            const char* a3 = a2 + kstep; const char* b3 = b2 + kstep;
            if constexpr (SP2) {
            PG8_LDB(B0, 0, 0); PG8_LDB(B1, 0, 1); PG8_SCHED; PG8_LDA(At, 0, 0); PG8_STAGE(PG8_SA(1, 1), a1 + hstepA, voffA);
            PG8_WAIT_V(8); PG8_WAIT_L(0); PG8_BAR; PG8_MMA(0, 0, At, B0); PG8_MMA(0, 1, At, B1); PG8_BAR; PG8_SCHED;
            PG8_LDA(At, 0, 1); PG8_STAGE(PG8_SB(0, 0), b2, voffB); PG8_STAGE(PG8_SB(0, 1), b2 + hstepB, voffB); PG8_STAGE(PG8_SA(0, 0), a2, voffA);
            PG8_WAIT_V(8); PG8_WAIT_L(0); PG8_BAR; PG8_MMA(1, 0, At, B0); PG8_MMA(1, 1, At, B1); PG8_BAR; PG8_SCHED;
            PG8_LDB(B0, 1, 0); PG8_LDB(B1, 1, 1); PG8_SCHED; PG8_LDA(At, 1, 0); PG8_STAGE(PG8_SA(0, 1), a2 + hstepA, voffA);
            PG8_WAIT_V(8); PG8_WAIT_L(0); PG8_BAR; PG8_MMA(0, 0, At, B0); PG8_MMA(0, 1, At, B1); PG8_BAR; PG8_SCHED;
            PG8_LDA(At, 1, 1); PG8_STAGE(PG8_SB(1, 0), b3, voffB); PG8_STAGE(PG8_SB(1, 1), b3 + hstepB, voffB); PG8_STAGE(PG8_SA(1, 0), a3, voffA);
            PG8_WAIT_V(8); PG8_WAIT_L(0); PG8_BAR; PG8_MMA(1, 0, At, B0); PG8_MMA(1, 1, At, B1); PG8_BAR; PG8_SCHED;
            } else {
            PG8_LDB(B0, 0, 0); PG8_SCHED; PG8_LDA(At, 0, 0); PG8_STAGE(PG8_SA(1, 1), a1 + hstepA, voffA);
            PG8_WAIT_L(8); PG8_BAR; PG8_WAIT_L(0); PG8_MMA(0, 0, At, B0); PG8_BAR; PG8_SCHED;
            PG8_LDB(B1, 0, 1); PG8_STAGE(PG8_SB(0, 0), b2, voffB);
            PG8_BAR; PG8_WAIT_L(0); PG8_MMA(0, 1, At, B1); PG8_BAR;
            PG8_LDA(At, 0, 1); PG8_STAGE(PG8_SA(0, 0), a2, voffA);
            PG8_BAR; PG8_WAIT_L(0); PG8_MMA(1, 0, At, B0); PG8_BAR; PG8_SCHED;
            PG8_STAGE(PG8_SB(0, 1), b2 + hstepB, voffB);
            PG8_WAIT_V(6); PG8_BAR; PG8_MMA(1, 1, At, B1); PG8_BAR;
            PG8_LDB(B0, 1, 0); PG8_SCHED; PG8_LDA(At, 1, 0); PG8_STAGE(PG8_SA(0, 1), a2 + hstepA, voffA);
            PG8_WAIT_L(8); PG8_BAR; PG8_WAIT_L(0); PG8_MMA(0, 0, At, B0); PG8_BAR; PG8_SCHED;
            PG8_LDB(B1, 1, 1); PG8_STAGE(PG8_SB(1, 0), b3, voffB);
            PG8_BAR; PG8_WAIT_L(0); PG8_MMA(0, 1, At, B1); PG8_BAR;
            PG8_LDA(At, 1, 1); PG8_STAGE(PG8_SA(1, 0), a3, voffA);
            PG8_BAR; PG8_WAIT_L(0); PG8_MMA(1, 0, At, B0); PG8_BAR; PG8_SCHED;
            PG8_STAGE(PG8_SB(1, 1), b3 + hstepB, voffB);
            PG8_WAIT_V(6); PG8_BAR; PG8_MMA(1, 1, At, B1); PG8_BAR;
            }
        }
        if constexpr (ALIGN_EPI) { if (wr == 0) PG8_BAR; }
        E(acc, cur, wr, wc, fr, fq, aux + (ui & 1) * 256);
        if (!has_next) break;
#pragma unroll
        for (int a = 0; a < 2; ++a)
#pragma unroll
            for (int b = 0; b < 2; ++b)
#pragma unroll
                for (int m = 0; m < 4; ++m)
#pragma unroll
                    for (int n = 0; n < 2; ++n) acc[a][b][m][n] = (f32x4){0.f, 0.f, 0.f, 0.f};
        cur = nxt; cA = nA; cB = nB; ++ui;
        if (rowss && tid < 256) aux[(ui & 1) * 256 + tid] = __builtin_amdgcn_rsqf(rowss[cur.pm * BM + tid] * (1.0f / 1024.0f) + 1e-5f);
        if constexpr (ALIGN_EPI) { if (wr == 1) PG8_BAR; }
    }
    PG8_WAIT_V(0);
    if constexpr (!ALIGN_EPI) { if (wr == 0) PG8_BAR; }
    PG8_BAR;
#undef PG8_SA
#undef PG8_SB
#undef PG8_STAGE
#undef PG8_LDA
#undef PG8_LDB
#undef PG8_MMA
#undef PG8_WAIT_V
#undef PG8_WAIT_L
#undef PG8_BAR
#undef PG8_SCHED
}
}
constexpr int NWAVES = 8;
constexpr int BATCH = 8, SEQ = 4096, DM = 1024, FF = 4096, M = BATCH * SEQ;
constexpr int N0 = 2816, N0G = 3072, N0SRC = 2840, N1 = 3072, N1SRC = 3088;
constexpr int C_MQ = 0, C_MK = 512, C_MV = 1024, C_NQ = 1536, C_KSL = 2304, C_VSL = 2432, C_KWN = 2560, C_VWN = 2688;
constexpr int C_FQ = 0, C_FK = 1024, C_FV = 2048;
constexpr float LOG2E = 1.4426950408889634f;
constexpr float C2 = 0.125f * LOG2E;

constexpr size_t MiB = 1u << 20;
constexpr size_t WS_CTL = 0, CTL_ZERO_BYTES = 1 * MiB;
constexpr size_t WS_WIN0 = 1 * MiB;
constexpr size_t WS_WOUT0 = WS_WIN0 + (size_t)N0G * 1024 * 2;
constexpr size_t WS_W1_0 = WS_WOUT0 + 2 * MiB;
constexpr size_t WS_W2_0 = WS_W1_0 + 8 * MiB;
constexpr size_t WS_WIN1 = WS_W2_0 + 8 * MiB;
constexpr size_t WS_WOUT1 = WS_WIN1 + 6 * MiB;
constexpr size_t WS_W1_1 = WS_WOUT1 + 2 * MiB;
constexpr size_t WS_W2_1 = WS_W1_1 + 8 * MiB;
constexpr size_t WS_WCMP = WS_W2_1 + 8 * MiB;
constexpr size_t WS_WG0 = WS_WCMP + 2 * MiB;
constexpr size_t WS_WF1 = WS_WG0 + 65536;
constexpr size_t WS_TB = WS_WF1 + 65536;
constexpr size_t WS_POSB = WS_TB + 65536;
constexpr size_t WS_W2T = WS_POSB + 4096;
constexpr size_t WS_SSQ = WS_W2T + 65536;
constexpr size_t WS_KMEAN = WS_SSQ + 4 * (size_t)M * 4;
constexpr size_t WS_MSEL = WS_KMEAN + 8 * 8 * 16 * 64 * 4;
constexpr size_t WS_SSEL = WS_MSEL + 8 * 8 * 4096 * 4;
constexpr size_t WS_GZ = WS_SSEL + 8 * 2 * 4096 * 8;
constexpr size_t WS_CK = WS_GZ + (size_t)M * 32 * 4;
constexpr size_t WS_CMPIN = WS_CK + 8 * 16 * 4096 * 4;
constexpr size_t WS_HID = WS_CMPIN + 2 * 16 * 4096 * 64 * 2 + 65536;
constexpr size_t WS_KVCMP = WS_HID + 8192 * 256 * 2;
constexpr size_t WS_OCMP = ((WS_KVCMP + 2 * 16 * 256 * 64 * 2 + MiB - 1) / MiB) * MiB;
constexpr size_t WS_KNT = WS_MSEL;
constexpr size_t WS_RT = WS_MSEL + 65536;
constexpr size_t WS_XL = WS_OCMP;
constexpr size_t WS_XB = WS_OCMP + (size_t)M * 512 * 4;
constexpr size_t WS_P = WS_XB + (size_t)M * 1024 * 2;
constexpr size_t WS_O = WS_P + (size_t)M * 3072 * 2;
constexpr size_t WS_A = WS_P;
constexpr size_t WS_END = WS_O + (size_t)M * 1024 * 2;
constexpr int CW_BAR = 4096, CW_QFOX = 8192, CW_QMOBA = 8256, CW_QNSA = 8320, CW_CMPDONE = 8384;

constexpr int RING_OFF = 0, RING_BYTES = 143360;
constexpr int LDSCTL_OFF = RING_BYTES, MISC_OFF = LDSCTL_OFF + 320;
constexpr int LDS_BYTES = 147456;

#define GAS __attribute__((address_space(1)))
#define LAS __attribute__((address_space(3)))
typedef unsigned short bf16;
typedef unsigned v4u __attribute__((ext_vector_type(4)));
typedef float f32x4 __attribute__((ext_vector_type(4)));
typedef float f32x16 __attribute__((ext_vector_type(16)));
typedef short bf16x8 __attribute__((ext_vector_type(8)));
typedef GAS unsigned gu32;
#define RLX_AGENT __ATOMIC_RELAXED, __HIP_MEMORY_SCOPE_AGENT
#define LDS_WAIT() asm volatile("s_waitcnt lgkmcnt(0)" ::: "memory")
#define VM_WAIT() asm volatile("s_waitcnt vmcnt(0)" ::: "memory")
__device__ __forceinline__ unsigned f2bf(float f) { unsigned u = __builtin_bit_cast(unsigned, f); return (u + 0x7fffu + ((u >> 16) & 1u)) >> 16; }
__device__ __forceinline__ unsigned pk2(float lo, float hi) { return f2bf(lo) | (f2bf(hi) << 16); }
__device__ __forceinline__ float bflo(unsigned w) { return __builtin_bit_cast(float, w << 16); }
__device__ __forceinline__ float bfhi(unsigned w) { return __builtin_bit_cast(float, w & 0xffff0000u); }
__device__ __forceinline__ float bf2f(bf16 h) { return __builtin_bit_cast(float, (unsigned)h << 16); }

#define XB_TMO      128
#define XB_XCNT(j)  (256  + 64 * (j))
#define XB_XSUB(j)  (1280 + 64 * (j))
#define XB_XGEN(j)  (2304 + 64 * (j))
#define XB_TOP      3328
#define XB_TOPGEN   3392
#define XCD_BAR_WORDS 3456
#define XB_SPIN_CAP (1u << 20)
__device__ __forceinline__ unsigned xb_ld(unsigned* p)              { return __hip_atomic_load(p, __ATOMIC_RELAXED, __HIP_MEMORY_SCOPE_AGENT); }
__device__ __forceinline__ unsigned xb_add(unsigned* p, unsigned v) { return __hip_atomic_fetch_add(p, v, __ATOMIC_RELAXED, __HIP_MEMORY_SCOPE_AGENT); }
__device__ __forceinline__ unsigned xb_xcc_id() { return (unsigned)__builtin_amdgcn_s_getreg((3 << 11) | 20) & 0xFu; }
#define XB_SPIN(cond, bar) do { unsigned _sp = 0; while (cond) { __builtin_amdgcn_s_sleep(1); \
    if ((++_sp & 255u) == 0u) { if (xb_ld(&(bar)[XB_TMO])) break; if (_sp > XB_SPIN_CAP) { atomicAdd(&(bar)[XB_TMO], 1u); break; } } } } while (0)
struct XcdBarrier { unsigned* bar; unsigned x; volatile LAS unsigned* st; };
__device__ __forceinline__ XcdBarrier xcd_barrier_post(unsigned* bar, volatile LAS unsigned* st) {
    XcdBarrier b; b.bar = bar; b.x = xb_xcc_id(); b.st = st;
    if (threadIdx.x == 0) (void)xb_add(&bar[XB_XCNT(b.x)], 1u);
    return b;
}
__device__ __forceinline__ void xcd_barrier_complete(unsigned* bar, unsigned x, unsigned& nloc, unsigned& nx) {
    const unsigned G = gridDim.x * gridDim.y * gridDim.z;
    unsigned sum, cnt, mine, sp = 0u;
    for (;;) {
        sum = 0u; cnt = 0u; mine = 0u;
#pragma unroll
        for (unsigned j = 0; j < 16; ++j) { const unsigned c = xb_ld(&bar[XB_XCNT(j)]); sum += c; cnt += (c > 0u) ? 1u : 0u; mine = (j == x) ? c : mine; }
        if (sum == G) break;
        __builtin_amdgcn_s_sleep(1);
        if ((++sp & 255u) == 0u) { if (xb_ld(&bar[XB_TMO])) break; if (sp > XB_SPIN_CAP) { atomicAdd(&bar[XB_TMO], 1u); break; } }
    }
    nloc = mine > 0u ? mine : 1u; nx = cnt > 0u ? cnt : 1u;
}
__device__ __forceinline__ void xcd_barrier(const XcdBarrier& b) {
    asm volatile("s_waitcnt vmcnt(0)" ::: "memory");
    __syncthreads();
    if (threadIdx.x == 0) {
        unsigned* bar = b.bar;
        __builtin_amdgcn_s_waitcnt(0);
        unsigned nloc = b.st[0], nx = b.st[1];
        if (nloc == 0u) { xcd_barrier_complete(bar, b.x, nloc, nx); b.st[0] = nloc; b.st[1] = nx; }
        const unsigned old = xb_add(&bar[XB_XSUB(b.x)], 1u);
        const unsigned gen = old / nloc;
        if (old + 1u == (gen + 1u) * nloc) {
            __builtin_amdgcn_fence(__ATOMIC_RELEASE, "agent");
            asm volatile("s_waitcnt vmcnt(0)" ::: "memory");
            const unsigned og = xb_add(&bar[XB_TOP], 1u);
            const unsigned tg = og / nx;
            if (og + 1u == (tg + 1u) * nx) xb_add(&bar[XB_TOPGEN], 1u);
            else XB_SPIN(xb_ld(&bar[XB_TOPGEN]) == tg, bar);
            __builtin_amdgcn_fence(__ATOMIC_ACQUIRE, "agent");
            xb_add(&bar[XB_XGEN(b.x)], 1u);
            asm volatile("s_waitcnt vmcnt(0)" ::: "memory");
        } else {
            XB_SPIN(xb_ld(&bar[XB_XGEN(b.x)]) == gen, bar);
            __builtin_amdgcn_fence(__ATOMIC_ACQUIRE, "agent");
            asm volatile("s_waitcnt vmcnt(0)" ::: "memory");
        }
    }
    __syncthreads();
}

struct Frame {
    LAS unsigned char* lds;
    volatile LAS unsigned* MISC;
    gu32* ctl;
    int tid, lane, wave;
    int vcu, G;
    int gw, NGW;
    unsigned char* ws;
};

__device__ __forceinline__ float wave_sum(float v) {
#pragma unroll
    for (int o = 1; o < 64; o <<= 1) v += __shfl_xor(v, o);
    return v;
}
__device__ __forceinline__ float wave_max(float v) {
#pragma unroll
    for (int o = 1; o < 64; o <<= 1) v = fmaxf(v, __shfl_xor(v, o));
    return v;
}
struct TrItem { const float* W; int K, Nsrc, Nuse; const float* gk; bf16* WT; int row_off, item; };
__device__ __forceinline__ void tr_load(const TrItem& d, int lane, f32x4 (&v)[8]) {
    const int nblk = d.Nuse / 32, kb = d.item / nblk, nb = d.item % nblk, k0 = 64 * kb, n0 = 32 * nb;
#pragma unroll
    for (int i = 0; i < 8; ++i) { const int kk = 8 * i + (lane >> 3); v[i] = *(const f32x4*)(d.W + (size_t)(k0 + kk) * d.Nsrc + n0 + 4 * (lane & 7)); if (d.gk) v[i] = v[i] * d.gk[k0 + kk]; }
}
__device__ __forceinline__ void tr_finish(const TrItem& d, int lane, const f32x4 (&v)[8], LAS float* scr) {
    const int nblk = d.Nuse / 32, kb = d.item / nblk, nb = d.item % nblk, k0 = 64 * kb, n0 = 32 * nb;
#pragma unroll
    for (int i = 0; i < 8; ++i) { const int kk = 8 * i + (lane >> 3); LAS float* t = scr + kk * 33 + 4 * (lane & 7); t[0] = v[i].x; t[1] = v[i].y; t[2] = v[i].z; t[3] = v[i].w; }
    LDS_WAIT(); asm volatile("" ::: "memory");
    const int c = lane & 7;
#pragma unroll
    for (int j = 0; j < 4; ++j) { const int n = (lane >> 3) + 8 * j; const LAS float* s = scr + (8 * c) * 33 + n;
        v4u o; o.x = pk2(s[0 * 33], s[1 * 33]); o.y = pk2(s[2 * 33], s[3 * 33]); o.z = pk2(s[4 * 33], s[5 * 33]); o.w = pk2(s[6 * 33], s[7 * 33]);
        *(GAS v4u*)(d.WT + (size_t)(d.row_off + n0 + n) * d.K + k0 + 8 * c) = o; }
    LDS_WAIT(); asm volatile("" ::: "memory");
}
__device__ __forceinline__ int t5_bucket(int d) {
    if (d < 16) return d;
    int b = 16;
    b += (d >= 21); b += (d >= 27); b += (d >= 35); b += (d >= 46); b += (d >= 59); b += (d >= 77); b += (d >= 99); b += (d >= 128);
    b += (d >= 166); b += (d >= 216); b += (d >= 280); b += (d >= 363); b += (d >= 470); b += (d >= 609); b += (d >= 790);
    return b;
}
struct Args { const float* in[18]; float* out; unsigned char* ws; int ph_lo, ph_hi; };
template <int BYTE_OFF> __device__ __forceinline__ const float* karg() {
    const char* ka = (const char*)__builtin_amdgcn_kernarg_segment_ptr(); unsigned long long v;
    asm volatile("s_load_dwordx2 %0, %1, %2\n\ts_waitcnt lgkmcnt(0)" : "=s"(v) : "s"(ka), "i"(BYTE_OFF));
    return (const float*)v;
}
#define KIN(k) karg<8 * (k)>()
#define KOUT() ((float*)karg<8 * 18>())
enum { I_X = 0, I_RELB, I_MIXN, I_MLPN, I_EWIN, I_EWOUT, I_POSK, I_POSV, I_CKW1, I_CKW2, I_CVW1, I_CVW2, I_OWIN, I_OBF, I_OWOUT, I_MW1, I_MW2, I_FN };

__device__ __forceinline__ void p0_prologue(Frame& F, const Args& a) {
    unsigned char* ws = F.ws;
    auto stream_x = [&](int m0, int m1, int xw, int NXW) __attribute__((always_inline)) {
#pragma unroll 1
        for (int m = m0 + xw; m < m1; m += 4 * NXW) {
            f32x4 v[4][4];
#pragma unroll
            for (int q = 0; q < 4; ++q) { const int mm = (m + q * NXW < m1) ? m + q * NXW : m; const GAS f32x4* xr = (const GAS f32x4*)(KIN(I_X) + (size_t)mm * 1024) + F.lane;
#pragma unroll
                for (int j = 0; j < 4; ++j) v[q][j] = __builtin_nontemporal_load(xr + 64 * j); }
            asm volatile("" ::: "memory");
#pragma unroll
            for (int q = 0; q < 4; ++q) { const int mm = m + q * NXW; if (mm < m1) {
                GAS unsigned long long* o8 = (GAS unsigned long long*)((bf16*)(ws + WS_XB) + (size_t)mm * 1024) + F.lane; float s = 0.f;
#pragma unroll
                for (int j = 0; j < 4; ++j) { const f32x4 w = v[q][j]; s += (w.x * w.x + w.y * w.y) + (w.z * w.z + w.w * w.w);
                    o8[64 * j] = (unsigned long long)pk2(w.x, w.y) | ((unsigned long long)pk2(w.z, w.w) << 32); }
                s = wave_sum(s); if (F.lane == 0) ((float*)(ws + WS_SSQ))[mm] = s; } }
        }
    };
    constexpr int M_MAIN = M;
    if (F.wave < 6) { stream_x(0, M_MAIN, F.vcu * 6 + F.wave, F.G * 6); return; }
    const int sw = F.vcu * 2 + (F.wave - 6), NSW = F.G * 2;
    LAS float* scr = (LAS float*)(F.lds + RING_OFF + F.wave * 16384);
    constexpr int I_IN0 = 16 * (N0 / 32), I_CW = 32 * 8;
    auto p0_item = [&](int r) __attribute__((always_inline)) -> TrItem {
        if (r < I_IN0) return TrItem{KIN(I_EWIN), 1024, N0SRC, N0, KIN(I_MIXN), (bf16*)(ws + WS_WIN0), 0, r};
        r -= I_IN0;
        if (r < I_CW) return TrItem{KIN(I_CKW1), 2048, 256, 256, nullptr, (bf16*)(ws + WS_WCMP), 0, r};
        return TrItem{KIN(I_CVW1), 2048, 256, 256, nullptr, (bf16*)(ws + WS_WCMP), 256, r - I_CW}; };
    for (int it = sw; it < I_IN0 + 2 * I_CW; it += 2 * NSW) {
        const bool two = it + NSW < I_IN0 + 2 * I_CW;
        const TrItem d0 = p0_item(it), d1 = p0_item(two ? it + NSW : it);
        f32x4 v0[8], v1[8]; tr_load(d0, F.lane, v0); if (two) tr_load(d1, F.lane, v1);
        asm volatile("" ::: "memory");
        tr_finish(d0, F.lane, v0, scr); if (two) tr_finish(d1, F.lane, v1, scr);
    }
    const int gt = sw * 64 + F.lane, NGT = NSW * 64;
    for (int i0 = gt; i0 < 256 * 1024; i0 += 8 * NGT) { float v[8];
#pragma unroll
        for (int q = 0; q < 8; ++q) { const int i = i0 + q * NGT, n = i >> 10, k = i & 1023; v[q] = 0.f;
            if (i < 256 * 1024 && n < 24) v[q] = KIN(I_EWIN)[(size_t)k * N0SRC + N0 + n] * KIN(I_MIXN)[k]; }
        asm volatile("" ::: "memory");
#pragma unroll
        for (int q = 0; q < 8; ++q) { const int i = i0 + q * NGT, n = i >> 10, k = i & 1023;
            if (i < 256 * 1024) ((bf16*)(ws + WS_WIN0))[(size_t)(N0 + n) * 1024 + k] = (bf16)f2bf(v[q]); } }
    for (int i = gt; i < 32 * 1024; i += NGT) { const int n = i >> 10, k = i & 1023; float v = 0.f;
        if (n < 16) v = KIN(I_OWIN)[(size_t)k * N1SRC + N1 + n] * KIN(I_MIXN)[1024 + k];
        ((bf16*)(ws + WS_WF1))[n * 1024 + k] = (bf16)f2bf(v); }
    for (int i = gt; i < 8 * 8 * 16 * 64; i += NGT) ((float*)(ws + WS_KMEAN))[i] = 0.f;
    for (int i = gt; i < 2 * 64 * 256; i += NGT) { const int w = i >> 14, d = (i >> 8) & 63, cc = i & 255; ((bf16*)(ws + WS_W2T))[i] = (bf16)f2bf((w ? KIN(I_CVW2) : KIN(I_CKW2))[cc * 64 + d]); }
    for (int i = gt; i < 16 * 1024; i += NGT) { const int h = i >> 10, d = i & 1023; ((float*)(ws + WS_TB))[i] = KIN(I_RELB)[t5_bucket(d) * 16 + h] * LOG2E; }
    for (int i = gt; i < 16 * 1280; i += NGT) { const int h = i / 1280, j = i - h * 1280; ((float*)(ws + WS_RT))[i] = (j < 1024) ? KIN(I_RELB)[t5_bucket(1023 - j) * 16 + h] * LOG2E : 0.f; }
    for (int i = NSW - 1 - sw; i < 512; i += NSW) { const int w = i >> 8, c = i & 255; const float* pos = (w ? KIN(I_POSV) : KIN(I_POSK)); const float* W1 = (w ? KIN(I_CVW1) : KIN(I_CKW1)); float s = 0.f;
#pragma unroll 8
        for (int k = 0; k < 32; ++k) s += pos[32 * F.lane + k] * W1[(size_t)(32 * F.lane + k) * 256 + c];
        s = wave_sum(s); if (F.lane == 0) ((float*)(ws + WS_POSB))[i] = s; }
    for (int i = gt; i < 3 * M; i += NGT) ((float*)(ws + WS_SSQ))[M + i] = 0.f;
    stream_x(M_MAIN, M, sw, NSW);
}

constexpr int LATE_SQ = 16 * 32, LATE_UP = 16 * 128, LATE_DN = 64 * 32, LATE_IN1 = 16 * (N1 / 32);
constexpr int LATE_ITEMS = LATE_SQ + LATE_UP + LATE_DN + LATE_IN1 + LATE_SQ + LATE_UP + LATE_DN, LATE_CHUNKS = (LATE_ITEMS + 63) / 64;
__device__ __forceinline__ void late_weight_chunk(Frame& F, int chunk) {
    LAS float* scr = (LAS float*)(F.lds + RING_OFF + F.wave * 16384); unsigned char* ws = F.ws;
    auto late_item = [&](int r) __attribute__((always_inline)) -> TrItem {
        if (r < LATE_SQ) return TrItem{KIN(I_EWOUT), 1024, 1024, 1024, nullptr, (bf16*)(ws + WS_WOUT0), 0, r};
        r -= LATE_SQ;
        if (r < LATE_UP) return TrItem{KIN(I_MW1), 1024, 4096, 4096, KIN(I_MLPN), (bf16*)(ws + WS_W1_0), 0, r};
        r -= LATE_UP;
        if (r < LATE_DN) return TrItem{KIN(I_MW2), 4096, 1024, 1024, nullptr, (bf16*)(ws + WS_W2_0), 0, r};
        r -= LATE_DN;
        if (r < LATE_IN1) return TrItem{KIN(I_OWIN), 1024, N1SRC, N1, KIN(I_MIXN) + 1024, (bf16*)(ws + WS_WIN1), 0, r};
        r -= LATE_IN1;
        if (r < LATE_SQ) return TrItem{KIN(I_OWOUT), 1024, 1024, 1024, nullptr, (bf16*)(ws + WS_WOUT1), 0, r};
        r -= LATE_SQ;
        if (r < LATE_UP) return TrItem{KIN(I_MW1) + (size_t)1024 * 4096, 1024, 4096, 4096, KIN(I_MLPN) + 1024, (bf16*)(ws + WS_W1_1), 0, r};
        r -= LATE_UP;
        return TrItem{KIN(I_MW2) + (size_t)4096 * 1024, 4096, 1024, 1024, nullptr, (bf16*)(ws + WS_W2_1), 0, r}; };
#pragma unroll 1
    for (int k = 0; k < 8; k += 2) { const int r = chunk * 64 + F.wave * 8 + k; if (r >= LATE_ITEMS) break;
        const bool two = r + 1 < LATE_ITEMS;
        const TrItem d0 = late_item(r), d1 = late_item(two ? r + 1 : r);
        f32x4 v0[8], v1[8]; tr_load(d0, F.lane, v0); if (two) tr_load(d1, F.lane, v1);
        asm volatile("" ::: "memory");
        tr_finish(d0, F.lane, v0, scr); if (two) tr_finish(d1, F.lane, v1, scr); }
}
__device__ __forceinline__ void skinny_gemm(Frame& F, const bf16* A, const bf16* Wt, const float* ssq, float* out) {
    typedef float f32x4_t __attribute__((ext_vector_type(4)));
    const int r16 = F.lane & 15, kg = F.lane >> 4;
    for (int it = F.gw; it < M / 16; it += F.NGW) {
        const int row0 = it * 16; f32x4_t acc = {0.f, 0.f, 0.f, 0.f};
        const bf16* ap = A + (size_t)(row0 + r16) * 1024 + kg * 8; const bf16* bp = Wt + (size_t)r16 * 1024 + kg * 8;
        float sq[4];
#pragma unroll
        for (int r = 0; r < 4; ++r) sq[r] = ssq[row0 + 4 * kg + r];
        bf16x8 a0[8], b0[8], a1[8], b1[8];
#pragma unroll
        for (int j = 0; j < 8; ++j) { a0[j] = *(const bf16x8*)(ap + j * 32); b0[j] = *(const bf16x8*)(bp + j * 32); }
#pragma unroll
        for (int h = 0; h < 2; ++h) {
#pragma unroll
            for (int j = 0; j < 8; ++j) { a1[j] = *(const bf16x8*)(ap + (16 * h + 8 + j) * 32); b1[j] = *(const bf16x8*)(bp + (16 * h + 8 + j) * 32); }
            asm volatile("" ::: "memory");
#pragma unroll
            for (int j = 0; j < 8; ++j) acc = __builtin_amdgcn_mfma_f32_16x16x32_bf16(a0[j], b0[j], acc, 0, 0, 0);
            if (h == 0) {
#pragma unroll
                for (int j = 0; j < 8; ++j) { a0[j] = *(const bf16x8*)(ap + (16 + j) * 32); b0[j] = *(const bf16x8*)(bp + (16 + j) * 32); } }
            asm volatile("" ::: "memory");
#pragma unroll
            for (int j = 0; j < 8; ++j) acc = __builtin_amdgcn_mfma_f32_16x16x32_bf16(a1[j], b1[j], acc, 0, 0, 0);
        }
#pragma unroll
        for (int r = 0; r < 4; ++r) { const int row = row0 + 4 * kg + r; out[(size_t)row * 32 + r16] = acc[r] * __builtin_amdgcn_rsqf(sq[r] * (1.0f / 1024.0f) + 1e-5f); }
    }
}

__device__ __forceinline__ void ph_fox_cum(Frame& F, const Args& a) {
    const float* FZ = (const float*)(F.ws + WS_GZ); float* CK = (float*)(F.ws + WS_CK); LAS float* sc = (LAS float*)(F.lds + RING_OFF);
    for (int it = F.vcu; it < 128; it += F.G) { const int b = it >> 4, h = it & 15; const float bfv = KIN(I_OBF)[h];
        float v[8]; float run = 0.f;
#pragma unroll
        for (int k = 0; k < 8; ++k) { const int t = F.tid * 8 + k; const float z = FZ[(size_t)(b * 4096 + t) * 32 + h] + bfv;
            const float ls = fminf(z, 0.f) - log1pf(__expf(-fabsf(z))); run += ls; v[k] = run; }
        sc[F.tid] = run; __syncthreads();
        for (int off = 1; off < 512; off <<= 1) { float add = (F.tid >= off) ? sc[F.tid - off] : 0.f; __syncthreads(); sc[F.tid] += add; __syncthreads(); }
        const float base = (F.tid > 0) ? sc[F.tid - 1] : 0.f;
#pragma unroll
        for (int k = 0; k < 8; ++k) CK[(size_t)it * 4096 + F.tid * 8 + k] = (base + v[k]) * LOG2E;
        __syncthreads(); }
}
__device__ __forceinline__ void ph_final_norm(Frame& F, const Args& a) {
    const GAS f32x4* gr = (const GAS f32x4*)(KIN(I_FN)) + F.lane;
    f32x4 gn[4];
#pragma unroll
    for (int j = 0; j < 4; ++j) gn[j] = gr[64 * j];
#pragma unroll 1
    for (int m = F.gw; m < M; m += 4 * F.NGW) {
        f32x4 v[4][4];
#pragma unroll
        for (int q = 0; q < 4; ++q) { const int mm = (m + q * F.NGW < M) ? m + q * F.NGW : m; const GAS f32x4* xr = (const GAS f32x4*)(KOUT() + (size_t)mm * 1024) + F.lane;
#pragma unroll
            for (int j = 0; j < 4; ++j) v[q][j] = xr[64 * j]; }
        asm volatile("" ::: "memory");
#pragma unroll
        for (int q = 0; q < 4; ++q) { const int mm = m + q * F.NGW; if (mm < M) { GAS f32x4* xw = (GAS f32x4*)(KOUT() + (size_t)mm * 1024) + F.lane; float s = 0.f;
#pragma unroll
            for (int j = 0; j < 4; ++j) s += (v[q][j].x * v[q][j].x + v[q][j].y * v[q][j].y) + (v[q][j].z * v[q][j].z + v[q][j].w * v[q][j].w);
            const float rs = 1.0f / sqrtf(wave_sum(s) * (1.0f / 1024.0f) + 1e-5f);
#pragma unroll
            for (int j = 0; j < 4; ++j) xw[64 * j] = v[q][j] * rs * gn[j]; } }
    }
}
namespace fa {
typedef short s16x4 __attribute__((ext_vector_type(4)));
typedef short v4i16_t __attribute__((ext_vector_type(4)));
typedef unsigned u32x4 __attribute__((ext_vector_type(4)));
typedef LAS const char* lds_cptr;
constexpr int SLOTB = 8192;
constexpr int L_K = 0, L_V = 2 * SLOTB, L_WS = 4 * SLOTB, L_OST = L_WS + NWAVES * 64 * 4, L_TB = L_OST + NWAVES * 8192, TB_STRIDE = 1280, L_CK = L_TB, L_IMP = L_TB + 4 * TB_STRIDE * 4 + 2048, L_SEL = L_IMP + 2 * 65 * 32 * 4, L_END = L_SEL + 64 * 8;
static_assert(L_END <= RING_BYTES, "flash LDS map");
constexpr float MASKV = -30000.0f, THR = 8.0f;
__device__ __forceinline__ int crow(int r, int hi) { return (r & 3) + 8 * (r >> 2) + 4 * hi; }
__device__ __forceinline__ unsigned cvtpk(float lo, float hi) { typedef float f2 __attribute__((ext_vector_type(2))); typedef __bf16 b2 __attribute__((ext_vector_type(2))); f2 v = {lo, hi}; b2 b = __builtin_convertvector(v, b2); return __builtin_bit_cast(unsigned, b); }
__device__ __forceinline__ s16x4 vtr(lds_cptr p) { return __builtin_bit_cast(s16x4, __builtin_amdgcn_ds_read_tr16_b64_v4i16((LAS v4i16_t*)p)); }
#define FA_BAR() asm volatile("s_waitcnt vmcnt(0) lgkmcnt(0)\n\ts_barrier" ::: "memory")

struct Ctx { int lane, r32, hi, wid; LAS unsigned char* shm; };

__device__ __forceinline__ void dma_kv(const Ctx& c, const bf16* Kg, const bf16* Vg, int pitch, int k0, int slot) {
    const bf16* ks = Kg + (size_t)(k0 + 8 * c.wid + (c.lane >> 3)) * pitch + ((c.lane & 7) ^ (c.lane >> 3)) * 8;
    const bf16* vs = Vg + (size_t)(k0 + 16 * (c.wid & 3) + (c.lane >> 2)) * pitch + (c.wid >> 2) * 32 + (c.lane & 3) * 8;
    __builtin_amdgcn_global_load_lds((const unsigned*)ks, (LAS unsigned*)(c.shm + L_K + slot * SLOTB + c.wid * 1024), 16, 0, 0);
    __builtin_amdgcn_global_load_lds((const unsigned*)vs, (LAS unsigned*)(c.shm + L_V + slot * SLOTB + c.wid * 1024), 16, 0, 0);
}
__device__ __forceinline__ void load_q(bf16x8 (&qr)[4], const bf16* qrow, int hi) {
#pragma unroll
    for (int d0 = 0; d0 < 4; ++d0) qr[d0] = *(const bf16x8*)(qrow + d0 * 16 + hi * 8);
}
struct State { f32x16 o[2]; float m, l, mt; };
__device__ __forceinline__ void reset(State& s) { s.o[0] = f32x16{}; s.o[1] = f32x16{}; s.m = 0.f; s.l = 0.f; s.mt = -1.0e30f; }

__device__ __forceinline__ void dma_k(const Ctx& c, const bf16* Kg, int pitch, int k0, int slot) {
    const bf16* ks = Kg + (size_t)(k0 + 8 * c.wid + (c.lane >> 3)) * pitch + ((c.lane & 7) ^ (c.lane >> 3)) * 8;
    __builtin_amdgcn_global_load_lds((const unsigned*)ks, (LAS unsigned*)(c.shm + L_K + slot * SLOTB + c.wid * 1024), 16, 0, 0);
}
__device__ __forceinline__ void dma_v(const Ctx& c, const bf16* Vg, int pitch, int k0, int slot) {
    const bf16* vs = Vg + (size_t)(k0 + 16 * (c.wid & 3) + (c.lane >> 2)) * pitch + (c.wid >> 2) * 32 + (c.lane & 3) * 8;
    __builtin_amdgcn_global_load_lds((const unsigned*)vs, (LAS unsigned*)(c.shm + L_V + slot * SLOTB + c.wid * 1024), 16, 0, 0);
}
__device__ __forceinline__ void dma_copy(const Ctx& c, const float* src, int lds_off, int pieces) {
    for (int p = c.wid; p < pieces; p += NWAVES)
        __builtin_amdgcn_global_load_lds((const unsigned*)(src + p * 256 + c.lane * 4), (LAS unsigned*)(c.shm + lds_off + p * 1024), 16, 0, 0);
}
__device__ __forceinline__ void qk_tile(const Ctx& c, int slot, const bf16x8 (&qr)[4], f32x16& c0, f32x16& c1) {
    const lds_cptr kb = (lds_cptr)(c.shm + L_K + slot * SLOTB) + c.r32 * 128;
#pragma unroll
    for (int d0 = 0; d0 < 4; ++d0) { const int co = ((2 * d0 + c.hi) ^ (c.r32 & 7)) * 16; const bf16x8 b0 = *(const LAS bf16x8*)(kb + co), b1 = *(const LAS bf16x8*)(kb + 4096 + co);
        c0 = __builtin_amdgcn_mfma_f32_32x32x16_bf16(b0, qr[d0], c0, 0, 0, 0); c1 = __builtin_amdgcn_mfma_f32_32x32x16_bf16(b1, qr[d0], c1, 0, 0, 0); }
}
__device__ __forceinline__ float max3a(float a, float b, float c) { float r; asm("v_max3_f32 %0, %1, %2, %3" : "=v"(r) : "v"(a), "v"(b), "v"(c)); return r; }
template <bool HAS_NEXT, bool ASMMAX, class Pol>
__device__ __forceinline__ void fa_step(const Ctx& c, Pol& pol, const bf16x8 (&qr)[4], State& st, f32x16& c0, f32x16& c1, f32x16& n0, f32x16& n1, int t, int slot, LAS float* wsf) {
    pol.mask(c0, c1, t);
    float rm;
    if (ASMMAX) { float a = max3a(c0[0], c0[1], c1[0]), b = max3a(c0[2], c0[3], c1[1]); a = max3a(a, c1[2], c1[3]);
#pragma unroll
        for (int r = 4; r < 16; r += 4) { a = max3a(a, c0[r], c0[r + 1]); b = max3a(b, c0[r + 2], c0[r + 3]); a = max3a(a, c1[r], c1[r + 1]); b = max3a(b, c1[r + 2], c1[r + 3]); }
        rm = max3a(a, b, b); }
    else { rm = fmaxf(c0[0], c1[0]);
#pragma unroll
        for (int r = 1; r < 16; ++r) rm = fmaxf(rm, fmaxf(c0[r], c1[r])); }
    { auto rr = __builtin_amdgcn_permlane32_swap(__float_as_uint(rm), __float_as_uint(rm), false, false); rm = fmaxf(__uint_as_float(rr[0]), __uint_as_float(rr[1])); }
    if constexpr (Pol::TRACK) pol.track(st, rm, t);
    if (__any(rm > THR)) {
        const float dl = fmaxf(rm, 0.f); st.m += dl;
#pragma unroll
        for (int r = 0; r < 16; ++r) { c0[r] -= dl; c1[r] -= dl; }
        const float f = __builtin_amdgcn_exp2f(-dl); st.l *= f;
        if (c.hi == 0) wsf[c.r32] = f;
        LDS_WAIT();
#pragma unroll
        for (int r = 0; r < 16; ++r) { const float fr = wsf[crow(r, c.hi)]; st.o[0][r] *= fr; st.o[1][r] *= fr; }
        LDS_WAIT();
    }
    if (HAS_NEXT) { pol.init(n0, n1, st.m, t + 1); qk_tile(c, slot ^ 1, qr, n0, n1); }
    float sacc = 0.f;
    const lds_cptr vp = (lds_cptr)(c.shm + L_V + slot * SLOTB) + ((c.lane >> 4) & 1) * 32 + (c.lane & 3) * 8 + (4 * c.hi + ((c.lane & 15) >> 2)) * 64;
    u32x4 pw[4];
#pragma unroll
    for (int r = 0; r < 16; ++r) { c0[r] = __builtin_amdgcn_exp2f(c0[r]); sacc += c0[r]; }
    pw[0] = (u32x4){cvtpk(c0[0], c0[1]), cvtpk(c0[2], c0[3]), cvtpk(c0[4], c0[5]), cvtpk(c0[6], c0[7])};
    pw[1] = (u32x4){cvtpk(c0[8], c0[9]), cvtpk(c0[10], c0[11]), cvtpk(c0[12], c0[13]), cvtpk(c0[14], c0[15])};
#pragma unroll
    for (int ks = 0; ks < 2; ++ks)
#pragma unroll
        for (int d0 = 0; d0 < 2; ++d0) { const s16x4 lo = vtr(vp + d0 * 4096 + ks * 1024), hh = vtr(vp + d0 * 4096 + ks * 1024 + 512);
            const bf16x8 vf = (bf16x8){lo[0], lo[1], lo[2], lo[3], hh[0], hh[1], hh[2], hh[3]};
            st.o[d0] = __builtin_amdgcn_mfma_f32_32x32x16_bf16(__builtin_bit_cast(bf16x8, pw[ks]), vf, st.o[d0], 0, 0, 0); }
#pragma unroll
    for (int r = 0; r < 16; ++r) { c1[r] = __builtin_amdgcn_exp2f(c1[r]); sacc += c1[r]; }
    st.l += sacc;
    pw[2] = (u32x4){cvtpk(c1[0], c1[1]), cvtpk(c1[2], c1[3]), cvtpk(c1[4], c1[5]), cvtpk(c1[6], c1[7])};
    pw[3] = (u32x4){cvtpk(c1[8], c1[9]), cvtpk(c1[10], c1[11]), cvtpk(c1[12], c1[13]), cvtpk(c1[14], c1[15])};
#pragma unroll
    for (int ks = 2; ks < 4; ++ks)
#pragma unroll
        for (int d0 = 0; d0 < 2; ++d0) { const s16x4 lo = vtr(vp + d0 * 4096 + ks * 1024), hh = vtr(vp + d0 * 4096 + ks * 1024 + 512);
            const bf16x8 vf = (bf16x8){lo[0], lo[1], lo[2], lo[3], hh[0], hh[1], hh[2], hh[3]};
            st.o[d0] = __builtin_amdgcn_mfma_f32_32x32x16_bf16(__builtin_bit_cast(bf16x8, pw[ks]), vf, st.o[d0], 0, 0, 0); }
}
template <class Pol>
__device__ __forceinline__ void issue_first(const Ctx& c, const Pol& pol, const bf16* Kg, const bf16* Vg, int pitch) {
    dma_k(c, Kg, pitch, pol.k0(0), 0); dma_v(c, Vg, pitch, pol.k0(0), 0);
    if (pol.nt > 1) dma_k(c, Kg, pitch, pol.k0(1), 1);
}
template <bool PRE = false, class Pol>
__device__ __forceinline__ void run_branch(const Ctx& c, Pol& pol, const bf16* Kg, const bf16* Vg, int pitch, const bf16x8 (&qr)[4], State& st) {
    const int NT = pol.nt;
    if (NT <= 0) return;
    LAS float* wsf = (LAS float*)(c.shm + L_WS) + c.wid * 64;
    if (!PRE) issue_first(c, pol, Kg, Vg, pitch);
    FA_BAR();
    f32x16 a0, a1, b0, b1;
    pol.init(a0, a1, st.m, 0); qk_tile(c, 0, qr, a0, a1);
    FA_BAR();
    int t = 0;
    for (; t + 2 < NT; t += 2) {
        dma_k(c, Kg, pitch, pol.k0(t + 2), 0); dma_v(c, Vg, pitch, pol.k0(t + 1), 1);
        fa_step<true, true>(c, pol, qr, st, a0, a1, b0, b1, t, 0, wsf);
        FA_BAR();
        if (t + 3 < NT) dma_k(c, Kg, pitch, pol.k0(t + 3), 1);
        dma_v(c, Vg, pitch, pol.k0(t + 2), 0);
        fa_step<true, true>(c, pol, qr, st, b0, b1, a0, a1, t + 1, 1, wsf);
        FA_BAR();
    }
    if (t + 1 < NT) {
        dma_v(c, Vg, pitch, pol.k0(t + 1), 1);
        fa_step<true, true>(c, pol, qr, st, a0, a1, b0, b1, t, 0, wsf);
        FA_BAR();
        fa_step<false, true>(c, pol, qr, st, b0, b1, a0, a1, t + 1, 1, wsf);
        FA_BAR();
    } else {
        fa_step<false, true>(c, pol, qr, st, a0, a1, b0, b1, t, 0, wsf);
        FA_BAR();
    }
}
template <class Pol>
__device__ __forceinline__ void run_branch_simple(const Ctx& c, Pol& pol, const bf16* Kg, const bf16* Vg, int pitch, const bf16x8 (&qr)[4], State& st) {
    const int NT = pol.nt;
    if (NT <= 0) return;
    LAS float* wsf = (LAS float*)(c.shm + L_WS) + c.wid * 64;
    dma_kv(c, Kg, Vg, pitch, pol.k0(0), 0);
    FA_BAR();
    for (int i = 0; i < NT; ++i) {
        if (i + 1 < NT) dma_kv(c, Kg, Vg, pitch, pol.k0(i + 1), (i & 1) ^ 1);
        f32x16 c0, c1;
        pol.init(c0, c1, st.m, i); qk_tile(c, i & 1, qr, c0, c1);
        fa_step<false, false>(c, pol, qr, st, c0, c1, c0, c1, i, i & 1, wsf);
        FA_BAR();
    }
}
__device__ __forceinline__ void row_to_regs(const Ctx& c, float v, float (&out)[16]) {
    LAS float* wsf = (LAS float*)(c.shm + L_WS) + c.wid * 64;
    if (c.hi == 0) wsf[c.r32] = v;
    LDS_WAIT();
#pragma unroll
    for (int r = 0; r < 16; ++r) out[r] = wsf[crow(r, c.hi)];
    LDS_WAIT();
}
__device__ __forceinline__ float total_l(float l) { auto rr = __builtin_amdgcn_permlane32_swap(__float_as_uint(l), __float_as_uint(l), false, false); return __uint_as_float(rr[0]) + __uint_as_float(rr[1]); }
__device__ __forceinline__ void store_o(const Ctx& c, const f32x16 (&o)[2], bf16* orow0) {
    LAS bf16* stg = (LAS bf16*)(c.shm + L_OST + c.wid * 8192);
#pragma unroll
    for (int r = 0; r < 16; ++r) { const int orow = crow(r, c.hi);
#pragma unroll
        for (int d0 = 0; d0 < 2; ++d0) stg[orow * 64 + d0 * 32 + c.r32] = (bf16)f2bf(o[d0][r]); }
    LDS_WAIT();
#pragma unroll
    for (int i = 0; i < 4; ++i) { const int row = i * 8 + (c.lane >> 3), ch = c.lane & 7; const u32x4 v = *(const LAS u32x4*)(stg + row * 64 + ch * 8); *(u32x4*)(orow0 + (size_t)row * 1024 + ch * 8) = v; }
    LDS_WAIT();
}

constexpr int L_KNP = L_TB + 16384, L_WSM = L_KNP + 512;
constexpr float FOX_MARGIN = 32.0f;
struct FoxPol {
    static constexpr bool TRACK = true;
    static constexpr bool LOWREG = false;
    int nt; int qpos; int hi; int lane; int wid; float cq; float qn; LAS const float* ckl; LAS const float* knp; LAS float* wsm;
    __device__ __forceinline__ int k0(int i) const { return 64 * (nt - 1 - i); }
    __device__ __forceinline__ void init(f32x16& c0, f32x16& c1, float m, int i) const {
        const float base = cq - m; LAS const float* p = ckl + 64 * (nt - 1 - i) + 4 * hi;
#pragma unroll
        for (int g = 0; g < 4; ++g) { const f32x4 a = *(LAS const f32x4*)(p + 8 * g), b = *(LAS const f32x4*)(p + 32 + 8 * g);
#pragma unroll
            for (int e = 0; e < 4; ++e) { c0[4 * g + e] = base - a[e]; c1[4 * g + e] = base - b[e]; } }
    }
    __device__ __forceinline__ void mask(f32x16& c0, f32x16& c1, int i) const {
        if (i < 4) { const int kb = 64 * (nt - 1 - i) + 4 * hi;
#pragma unroll
            for (int r = 0; r < 16; ++r) { const int kv = kb + (r & 3) + 8 * (r >> 2); if (kv > qpos) c0[r] = MASKV; if (kv + 32 > qpos) c1[r] = MASKV; } }
    }
    __device__ __forceinline__ void track(State& st, float rm, int i) const {
        st.mt = fmaxf(st.mt, st.m + rm);
        if (i & 1) { float s = st.mt - cq - qn * knp[nt - 1 - i] - 0.05f;
#pragma unroll
            for (int o = 1; o < 64; o <<= 1) s = fminf(s, __shfl_xor(s, o));
            if (lane == 0) wsm[wid] = s; }
    }
};
template <bool PRE = false, class Pol>
__device__ __forceinline__ void run_branch_fox(const Ctx& c, Pol& pol, const bf16* Kg, const bf16* Vg, int pitch, const bf16x8 (&qr)[4], State& st) {
    const int NT = pol.nt; int NTe = NT;
    LAS float* wsf = (LAS float*)(c.shm + L_WS) + c.wid * 64;
    if (!PRE) issue_first(c, pol, Kg, Vg, pitch);
    FA_BAR();
    f32x16 a0, a1, b0, b1;
    pol.init(a0, a1, st.m, 0); qk_tile(c, 0, qr, a0, a1);
    FA_BAR();
    int t = 0;
    for (;; t += 2) {
        if (t >= 2 && t < NTe) {
            float smin = pol.wsm[0];
#pragma unroll
            for (int w = 1; w < NWAVES; ++w) smin = fminf(smin, pol.wsm[w]);
            const float lim = smin - FOX_MARGIN; const int T0 = NT - 1 - t;
            int first = 3;
            if (T0 >= 2 && -pol.ckl[64 * (T0 - 2) + 63] < lim) first = 2;
            if (T0 >= 1 && -pol.ckl[64 * (T0 - 1) + 63] < lim) first = 1;
            if (-pol.ckl[64 * T0 + 63] < lim) first = 0;
            first = __builtin_amdgcn_readfirstlane(first);
            if (first < 3 && t + first < NTe) NTe = t + first;
        }
        if (!(t + 2 < NTe)) break;
        dma_k(c, Kg, pitch, pol.k0(t + 2), 0); dma_v(c, Vg, pitch, pol.k0(t + 1), 1);
        fa_step<true, true>(c, pol, qr, st, a0, a1, b0, b1, t, 0, wsf);
        FA_BAR();
        if (t + 3 < NTe) dma_k(c, Kg, pitch, pol.k0(t + 3), 1);
        dma_v(c, Vg, pitch, pol.k0(t + 2), 0);
        fa_step<true, true>(c, pol, qr, st, b0, b1, a0, a1, t + 1, 1, wsf);
        FA_BAR();
    }
    if (t + 1 < NTe) {
        dma_v(c, Vg, pitch, pol.k0(t + 1), 1);
        fa_step<true, true>(c, pol, qr, st, a0, a1, b0, b1, t, 0, wsf);
        FA_BAR();
        fa_step<false, true>(c, pol, qr, st, b0, b1, a0, a1, t + 1, 1, wsf);
        FA_BAR();
    } else if (t < NTe) {
        fa_step<false, true>(c, pol, qr, st, a0, a1, b0, b1, t, 0, wsf);
        FA_BAR();
    }
}
__device__ __forceinline__ void fox_unit(Frame& F, int b, int h, int qb) {
    Ctx c; { int l_ = F.lane; asm volatile("" : "+v"(l_)); c.lane = l_; } c.r32 = c.lane & 31; c.hi = c.lane >> 5; c.wid = F.wave; c.shm = F.lds + RING_OFF;
    const bf16* P = (const bf16*)(F.ws + WS_P); const float* CK = (const float*)(F.ws + WS_CK) + (size_t)(b * 16 + h) * 4096; bf16* O = (bf16*)(F.ws + WS_O);
    const float* KNT = (const float*)(F.ws + WS_KNT) + (b * 16 + h) * 64;
    const int q0 = qb * 256; const size_t rowbase = (size_t)b * 4096;
    LAS float* ckl = (LAS float*)(c.shm + L_CK); LAS float* knp = (LAS float*)(c.shm + L_KNP); LAS float* wsm = (LAS float*)(c.shm + L_WSM);
    const int tid = c.wid * 64 + c.lane;
    FoxPol pol; pol.nt = (q0 + 256) / 64;
    issue_first(c, pol, P + rowbase * N1 + C_FK + h * 64, P + rowbase * N1 + C_FV + h * 64, N1);
    dma_copy(c, CK, L_CK, qb + 1);
    if (tid < 64) { float v = KNT[tid];
#pragma unroll
        for (int o = 1; o < 64; o <<= 1) { const float u = __shfl_up(v, o); if (c.lane >= o) v = fmaxf(v, u); }
        knp[tid] = v; }
    const int qpos = q0 + c.wid * 32 + c.r32;
    bf16x8 qr[4]; load_q(qr, P + (rowbase + qpos) * N1 + C_FQ + h * 64, c.hi);
    float ss = 0.f;
#pragma unroll
    for (int d0 = 0; d0 < 4; ++d0)
#pragma unroll
        for (int e = 0; e < 8; ++e) { const float v = bf2f((bf16)qr[d0][e]); ss += v * v; }
    { auto rr = __builtin_amdgcn_permlane32_swap(__float_as_uint(ss), __float_as_uint(ss), false, false); ss = __uint_as_float(rr[0]) + __uint_as_float(rr[1]); }
    pol.qpos = qpos; pol.hi = c.hi; pol.lane = c.lane; pol.wid = c.wid; pol.cq = CK[qpos]; pol.qn = sqrtf(ss) * 1.001f; pol.ckl = ckl; pol.knp = knp; pol.wsm = wsm;
    State st; reset(st);
    __syncthreads();
    run_branch_fox<true>(c, pol, P + rowbase * N1 + C_FK + h * 64, P + rowbase * N1 + C_FV + h * 64, N1, qr, st);
    float rl[16]; row_to_regs(c, 1.0f / total_l(st.l), rl);
#pragma unroll
    for (int r = 0; r < 16; ++r) { st.o[0][r] *= rl[r]; st.o[1][r] *= rl[r]; }
    store_o(c, st.o, O + (rowbase + q0 + c.wid * 32) * 1024 + h * 64);
    __syncthreads();
}
__device__ __forceinline__ void ph_fox_flash(Frame& F) {
    if (F.wave >= 4) __builtin_amdgcn_s_setprio(1);
    unsigned* ctr = (unsigned*)(F.ctl + CW_QFOX); LAS int* nxt = (LAS int*)(F.lds + RING_OFF + L_WSM + 64);
#pragma unroll 1
    for (;;) {
        if (F.tid == 0) *nxt = (int)__hip_atomic_fetch_add(ctr, 1u, __ATOMIC_RELAXED, __HIP_MEMORY_SCOPE_AGENT);
        __syncthreads();
        const int u = __builtin_amdgcn_readfirstlane(*nxt);
        if (u >= 2048) break;
        const int bh = u & 127; fox_unit(F, bh >> 4, bh & 15, 15 - (u >> 7));
    }
    __builtin_amdgcn_s_setprio(0);
}
__device__ __forceinline__ void ph_fox_knorm(Frame& F) {
    const bf16* P = (const bf16*)(F.ws + WS_P); float* KNT = (float*)(F.ws + WS_KNT);
    const int kw = (F.G > 128) ? (F.vcu - 128) * NWAVES + F.wave : F.gw, NKW = (F.G > 128) ? (F.G - 128) * NWAVES : F.NGW;
    if (kw < 0) return;
    for (int it0 = kw; it0 < 128 * 64; it0 += 2 * NKW) {
        v4u w[2][8];
#pragma unroll
        for (int q = 0; q < 2; ++q) { const int it = (it0 + q * NKW < 128 * 64) ? it0 + q * NKW : it0; const int T = it & 63, bh = it >> 6, b = bh >> 4, h = bh & 15;
            const bf16* kp = P + ((size_t)b * 4096 + T * 64 + (F.lane >> 3)) * N1 + C_FK + h * 64 + (F.lane & 7) * 8;
#pragma unroll
            for (int j = 0; j < 8; ++j) w[q][j] = *(const v4u*)(kp + (size_t)(8 * j) * N1); }
        asm volatile("" ::: "memory");
#pragma unroll
        for (int q = 0; q < 2; ++q) { const int it = it0 + q * NKW; if (it < 128 * 64) { float mx = 0.f;
#pragma unroll
            for (int j = 0; j < 8; ++j) { const v4u x = w[q][j];
                float ss = bflo(x.x) * bflo(x.x) + bfhi(x.x) * bfhi(x.x) + bflo(x.y) * bflo(x.y) + bfhi(x.y) * bfhi(x.y) + bflo(x.z) * bflo(x.z) + bfhi(x.z) * bfhi(x.z) + bflo(x.w) * bflo(x.w) + bfhi(x.w) * bfhi(x.w);
                ss += __shfl_xor(ss, 1); ss += __shfl_xor(ss, 2); ss += __shfl_xor(ss, 4); mx = fmaxf(mx, ss); }
            mx = wave_max(mx); if (F.lane == 0) KNT[it] = sqrtf(mx) * 1.0001f; } }
    }
}
__device__ __forceinline__ void stage_table(const Frame& F, LAS float* rt, const float* tbh) {
    for (int j = F.tid; j < TB_STRIDE; j += NWAVES * 64) rt[j] = (j < 1024) ? tbh[1023 - j] : 0.f;
}
__device__ __forceinline__ void init_table(f32x16& c0, f32x16& c1, float base, LAS const float* p) {
#pragma unroll
    for (int r = 0; r < 16; ++r) { const int ko = (r & 3) + 8 * (r >> 2); c0[r] = base + p[ko]; c1[r] = base + p[32 + ko]; }
}
__device__ __forceinline__ void init_const(f32x16& c0, f32x16& c1, float v) {
#pragma unroll
    for (int r = 0; r < 16; ++r) { c0[r] = v; c1[r] = v; }
}
__device__ __forceinline__ void mask_causal(f32x16& c0, f32x16& c1, int kb  , int qpos) {
#pragma unroll
    for (int r = 0; r < 16; ++r) { const int kv = kb + (r & 3) + 8 * (r >> 2); if (kv > qpos) c0[r] = MASKV; if (kv + 32 > qpos) c1[r] = MASKV; }
}
struct MobaPol {
    static constexpr bool TRACK = false;
    static constexpr bool LOWREG = false;
    int nt, blk, qpos, q0w, hi; unsigned msel; LAS const float* rt; float c31;
    __device__ __forceinline__ int k0(int i) const { return 64 * i; }
    __device__ __forceinline__ void init(f32x16& c0, f32x16& c1, float m, int i) const {
        const int n = i >> 2; const bool sel = (n == blk) || ((msel >> n) & 1u); const float base = sel ? -m : MASKV;
        if (q0w - 64 * i - 63 < 790) init_table(c0, c1, base, rt + (1023 - qpos + 64 * i + 4 * hi));
        else init_const(c0, c1, base + c31);
    }
    __device__ __forceinline__ void mask(f32x16& c0, f32x16& c1, int i) const { if (i >= nt - 4) mask_causal(c0, c1, 64 * i + 4 * hi, qpos); }
};
__device__ __forceinline__ void moba_unit(Frame& F, int b, int h, int blk) {
    Ctx c; { int l_ = F.lane; asm volatile("" : "+v"(l_)); c.lane = l_; } c.r32 = c.lane & 31; c.hi = c.lane >> 5; c.wid = F.wave; c.shm = F.lds + RING_OFF;
    const bf16* P = (const bf16*)(F.ws + WS_P); const float* TB = (const float*)(F.ws + WS_TB) + h * 1024; bf16* O = (bf16*)(F.ws + WS_O);
    const int q0 = blk * 256; const size_t rowbase = (size_t)b * 4096;
    LAS float* rt = (LAS float*)(c.shm + L_TB);
    MobaPol pol; pol.nt = 4 * (blk + 1);
    issue_first(c, pol, P + rowbase * N0 + C_MK + h * 64, P + rowbase * N0 + C_MV + h * 64, N0);
    dma_copy(c, (const float*)(F.ws + WS_RT) + h * TB_STRIDE, L_TB, 5);
    const int qpos = q0 + c.wid * 32 + c.r32;
    bf16x8 qr[4]; load_q(qr, P + (rowbase + qpos) * N0 + C_MQ + h * 64, c.hi);
    unsigned msel = 0u;
    if (blk > 0) {
        const float* KM = (const float*)(F.ws + WS_KMEAN) + (size_t)((b * 8 + h) * 16) * 64;
        f32x16 rs = {};
        f32x4 kx[4][2];
#pragma unroll
        for (int d0 = 0; d0 < 4; ++d0) { const float* kp = KM + (c.r32 & 15) * 64 + d0 * 16 + c.hi * 8; kx[d0][0] = *(const f32x4*)kp; kx[d0][1] = *(const f32x4*)(kp + 4); }
#pragma unroll
        for (int d0 = 0; d0 < 4; ++d0) { bf16x8 ah = {}, al = {};
            if (c.r32 < 16) { const f32x4 x0 = kx[d0][0], x1 = kx[d0][1];
#pragma unroll
                for (int e = 0; e < 4; ++e) { const unsigned h0 = f2bf(x0[e]), h1 = f2bf(x1[e]); ah[e] = (short)h0; ah[4 + e] = (short)h1;
                    al[e] = (short)f2bf(x0[e] - bf2f((bf16)h0)); al[4 + e] = (short)f2bf(x1[e] - bf2f((bf16)h1)); } }
            rs = __builtin_amdgcn_mfma_f32_32x32x16_bf16(ah, qr[d0], rs, 0, 0, 0); rs = __builtin_amdgcn_mfma_f32_32x32x16_bf16(al, qr[d0], rs, 0, 0, 0); }
        float own[8], oth[8];
#pragma unroll
        for (int i = 0; i < 8; ++i) { own[i] = rs[i]; auto rr = __builtin_amdgcn_permlane32_swap(__float_as_uint(own[i]), __float_as_uint(own[i]), false, false); oth[i] = __uint_as_float(c.hi ? rr[0] : rr[1]); }
#pragma unroll
        for (int r = 0; r < 3; ++r) { float best = -3.0e38f; int bi = 99;
#pragma unroll
            for (int i = 0; i < 8; ++i) { const int no = (i & 3) + 8 * (i >> 2) + 4 * c.hi, np = (i & 3) + 8 * (i >> 2) + 4 * (1 - c.hi);
                if (no < blk && !((msel >> no) & 1u) && (own[i] > best || (own[i] == best && no < bi))) { best = own[i]; bi = no; }
                if (np < blk && !((msel >> np) & 1u) && (oth[i] > best || (oth[i] == best && np < bi))) { best = oth[i]; bi = np; } }
            if (bi < 16) msel |= 1u << bi; }
    }
    pol.blk = blk; pol.qpos = qpos; pol.q0w = q0 + c.wid * 32; pol.hi = c.hi; pol.msel = msel; pol.rt = rt; pol.c31 = TB[1023];
    State st; reset(st);
    __syncthreads();
    run_branch<true>(c, pol, P + rowbase * N0 + C_MK + h * 64, P + rowbase * N0 + C_MV + h * 64, N0, qr, st);
    float rl[16]; row_to_regs(c, 1.0f / total_l(st.l), rl);
#pragma unroll
    for (int r = 0; r < 16; ++r) { st.o[0][r] *= rl[r]; st.o[1][r] *= rl[r]; }
    store_o(c, st.o, O + (rowbase + q0 + c.wid * 32) * 1024 + h * 64);
    __syncthreads();
}
__device__ __forceinline__ void ph_moba_flash(Frame& F) {
    if (F.wave >= 4) __builtin_amdgcn_s_setprio(1);
    unsigned* ctr = (unsigned*)(F.ctl + CW_QMOBA); LAS int* nxt = (LAS int*)(F.lds + RING_OFF + L_WS + NWAVES * 64 * 4 - 16);
#pragma unroll 1
    for (;;) {
        if (F.tid == 0) *nxt = (int)__hip_atomic_fetch_add(ctr, 1u, __ATOMIC_RELAXED, __HIP_MEMORY_SCOPE_AGENT);
        __syncthreads();
        const int u = __builtin_amdgcn_readfirstlane(*nxt);
        if (u >= 1024 + LATE_CHUNKS) break;
        int mu = u - LATE_CHUNKS;
        if (u < 6 * LATE_CHUNKS) { if (u % 6 == 5) { late_weight_chunk(F, u / 6); __syncthreads(); continue; } mu = u - u / 6; }
        const int bh = mu & 63; moba_unit(F, bh >> 3, bh & 7, 15 - (mu >> 6));
    }
    __builtin_amdgcn_s_setprio(0);
}
__device__ __forceinline__ void cmp2_tile(Frame& F, int pm) {
    asm volatile("s_waitcnt vmcnt(0)" ::: "memory"); __syncthreads();
    const int lane = F.lane, r32 = lane & 31, hi = lane >> 5, w8 = F.wave, w = pm >> 4;
    const bf16* A = (const bf16*)(F.ws + WS_HID) + (size_t)(pm * 256 + 32 * w8 + r32) * 256 + hi * 8;
#pragma unroll
    for (int cb = 0; cb < 2; ++cb) {
        const bf16* W2 = (const bf16*)(F.ws + WS_W2T) + (size_t)(w * 64 + 32 * cb + r32) * 256 + hi * 8; f32x16 o = {};
#pragma unroll
        for (int ks = 0; ks < 16; ++ks) { const bf16x8 av = *(const bf16x8*)(A + ks * 16), bv = *(const bf16x8*)(W2 + ks * 16); o = __builtin_amdgcn_mfma_f32_32x32x16_bf16(av, bv, o, 0, 0, 0); }
        bf16* KV = (bf16*)(F.ws + WS_KVCMP) + ((size_t)pm * 256 + 32 * w8) * 64 + 32 * cb + r32;
#pragma unroll
        for (int r = 0; r < 16; ++r) KV[(size_t)((r & 3) + 8 * (r >> 2) + 4 * hi) * 64] = (bf16)f2bf(o[r]);
    }
}
struct SlcPol {
    static constexpr bool TRACK = false;
    static constexpr bool LOWREG = true;
    int nt, qpos, q0w, hi; unsigned long long ssel; LAS const float* rt; float c31;
    __device__ __forceinline__ int k0(int i) const { return 64 * i; }
    __device__ __forceinline__ void init(f32x16& c0, f32x16& c1, float m, int i) const {
        const bool sel = (ssel >> i) & 1ull; const float base = sel ? -m : MASKV;
        if (q0w - 64 * i - 63 < 790) init_table(c0, c1, base, rt + (1023 - qpos + 64 * i + 4 * hi));
        else init_const(c0, c1, base + c31);
    }
    __device__ __forceinline__ void mask(f32x16& c0, f32x16& c1, int i) const { if (i == nt - 1) mask_causal(c0, c1, 64 * i + 4 * hi, qpos); }
};
struct WinPol {
    static constexpr bool TRACK = false;
    static constexpr bool LOWREG = true;
    int nt, t0, sb, qpos, hi; LAS const float* rt;
    __device__ __forceinline__ int k0(int i) const { return 64 * (t0 + i); }
    __device__ __forceinline__ void init(f32x16& c0, f32x16& c1, float m, int i) const { init_table(c0, c1, -m, rt + (1023 - qpos + 64 * (t0 + i) + 4 * hi)); }
    __device__ __forceinline__ void mask(f32x16& c0, f32x16& c1, int i) const {
        const int tb = t0 + i, kb = 64 * tb + 4 * hi;
        if (tb == sb) mask_causal(c0, c1, kb, qpos);
        if (tb == sb - 8) {
#pragma unroll
            for (int r = 0; r < 16; ++r) { const int kv = kb + (r & 3) + 8 * (r >> 2); if (qpos - kv > 511) c0[r] = MASKV; if (qpos - kv - 32 > 511) c1[r] = MASKV; } }
    }
};
struct CmpPol {
    static constexpr bool TRACK = false;
    static constexpr bool LOWREG = true;
    int nt, qpos, hi; LAS const float* rt;
    __device__ __forceinline__ int k0(int i) const { return 64 * i; }
    __device__ __forceinline__ void init(f32x16& c0, f32x16& c1, float m, int i) const {
        const int ib = 1054 - qpos + 16 * (64 * i + 4 * hi);
#pragma unroll
        for (int r = 0; r < 16; ++r) { const int ko = 16 * ((r & 3) + 8 * (r >> 2)); const int i0 = ib + ko, i1 = ib + ko + 512;
            c0[r] = rt[i0 > 0 ? i0 : 0] - m; c1[r] = rt[i1 > 0 ? i1 : 0] - m; if ((r & 3) == 3) asm volatile("" ::: "memory"); }
    }
    __device__ __forceinline__ void mask(f32x16& c0, f32x16& c1, int i) const {
        const int nb = 64 * i + 4 * hi;
#pragma unroll
        for (int r = 0; r < 16; ++r) { const int n = nb + (r & 3) + 8 * (r >> 2); if (16 * n + 31 > qpos) c0[r] = MASKV; if (16 * (n + 32) + 31 > qpos) c1[r] = MASKV; }
    }
};
__device__ __forceinline__ void nsa_unit(Frame& F, int b, int g, int qblk) {
    Ctx c; { int l_ = F.lane; asm volatile("" : "+v"(l_)); c.lane = l_; } c.r32 = c.lane & 31; c.hi = c.lane >> 5; c.wid = F.wave; c.shm = F.lds + RING_OFF;
    const bf16* P = (const bf16*)(F.ws + WS_P); const float* TB = (const float*)(F.ws + WS_TB); bf16* O = (bf16*)(F.ws + WS_O);
    const bf16* KVC = (const bf16*)(F.ws + WS_KVCMP); const float* GZ = (const float*)(F.ws + WS_GZ);
    const int q0 = qblk * 64, sb = qblk; const size_t rowbase = (size_t)b * 4096;
    const int j = c.wid >> 1, sub = c.wid & 1, hn = 4 * g + j;
    const bf16* Kc = KVC + (size_t)((0 * 16 + b * 2 + g) * 256) * 64; const bf16* Vc = KVC + (size_t)((1 * 16 + b * 2 + g) * 256) * 64;
    CmpPol cpol; cpol.nt = (4 * qblk + 3 + 63) >> 6;
    issue_first(c, cpol, Kc, Vc, 64);
    dma_copy(c, (const float*)(F.ws + WS_RT) + (8 + 4 * g) * TB_STRIDE, L_TB, 20);
    LAS const float* rt = (LAS const float*)(c.shm + L_TB) + j * TB_STRIDE;
    LAS unsigned* impfx = (LAS unsigned*)(c.shm + L_IMP);
    LAS unsigned long long* sel64 = (LAS unsigned long long*)(c.shm + L_SEL);
    for (int i = F.tid; i < 2 * 65 * 32; i += NWAVES * 64) impfx[i] = 0u;
    const int qpos = q0 + sub * 32 + c.r32; const size_t row = rowbase + qpos;
    bf16x8 qr[4]; load_q(qr, P + row * N0 + C_NQ + hn * 64, c.hi);
    const float g0 = 1.f / (1.f + __expf(-GZ[row * 32 + hn * 3 + 0])), g1 = 1.f / (1.f + __expf(-GZ[row * 32 + hn * 3 + 1])), g2 = 1.f / (1.f + __expf(-GZ[row * 32 + hn * 3 + 2]));
    LAS float* park = (LAS float*)(c.shm + L_OST + c.wid * 8192);
    State st; reset(st);
    __syncthreads();
    {   CmpPol& pol = cpol; pol.qpos = qpos; pol.hi = c.hi; pol.rt = rt;
        run_branch<true>(c, pol, Kc, Vc, 64, qr, st);
        const float lt = total_l(st.l); const float inv = (lt > 0.f) ? 1.0f / lt : 0.f;
        { float rl[16]; row_to_regs(c, g0 * inv, rl);
#pragma unroll
          for (int r = 0; r < 16; ++r) { park[r * 128 + c.lane] = st.o[0][r] * rl[r]; park[r * 128 + 64 + c.lane] = st.o[1][r] * rl[r]; } }
        const float sc = inv * 16777216.0f;
        dma_kv(c, Kc, Vc, 64, 0, 0); FA_BAR();
        for (int i = 0; i < pol.nt; ++i) { const int slot = i & 1;
            if (i + 1 < pol.nt) dma_kv(c, Kc, Vc, 64, 64 * (i + 1), slot ^ 1);
            f32x16 c0, c1; pol.init(c0, c1, st.m, i);
            qk_tile(c, slot, qr, c0, c1);
            pol.mask(c0, c1, i);
            LAS unsigned* ib = impfx + (sub * 65 + 16 * i + c.hi) * 32 + c.r32;
#pragma unroll
            for (int gq = 0; gq < 4; ++gq) {
                const float a0 = __builtin_amdgcn_exp2f(c0[4 * gq]) * sc, a1 = __builtin_amdgcn_exp2f(c0[4 * gq + 1]) * sc, a2 = __builtin_amdgcn_exp2f(c0[4 * gq + 2]) * sc, a3 = __builtin_amdgcn_exp2f(c0[4 * gq + 3]) * sc;
                const float b0 = __builtin_amdgcn_exp2f(c1[4 * gq]) * sc, b1 = __builtin_amdgcn_exp2f(c1[4 * gq + 1]) * sc, b2 = __builtin_amdgcn_exp2f(c1[4 * gq + 2]) * sc, b3 = __builtin_amdgcn_exp2f(c1[4 * gq + 3]) * sc;
                const unsigned ua3 = (unsigned)(a3 + 0.5f), ub3 = (unsigned)(b3 + 0.5f);
                const unsigned ua = (unsigned)(a0 + 0.5f) + (unsigned)(a1 + 0.5f) + (unsigned)(a2 + 0.5f) + ua3, ub = (unsigned)(b0 + 0.5f) + (unsigned)(b1 + 0.5f) + (unsigned)(b2 + 0.5f) + ub3;
                __hip_atomic_fetch_add(ib + (2 * gq) * 32, ua, __ATOMIC_RELAXED, __HIP_MEMORY_SCOPE_WORKGROUP); __hip_atomic_fetch_add(ib + (2 * gq + 1) * 32, ua3, __ATOMIC_RELAXED, __HIP_MEMORY_SCOPE_WORKGROUP);
                __hip_atomic_fetch_add(ib + (8 + 2 * gq) * 32, ub, __ATOMIC_RELAXED, __HIP_MEMORY_SCOPE_WORKGROUP); __hip_atomic_fetch_add(ib + (8 + 2 * gq + 1) * 32, ub3, __ATOMIC_RELAXED, __HIP_MEMORY_SCOPE_WORKGROUP);
            }
            FA_BAR();
        }
    }
    SlcPol spol; spol.nt = sb + 1;
    issue_first(c, spol, P + rowbase * N0 + C_KSL + g * 64, P + rowbase * N0 + C_VSL + g * 64, N0);
    for (int k = 0; k < 8; ++k) { const int qq = c.wid * 8 + k; const int m = c.lane;
        const unsigned v = impfx[((qq >> 5) * 65 + m) * 32 + (qq & 31)];
        const bool valid = m <= sb, forced = (m == 0) || (m == sb) || (m == sb - 1);
        const unsigned key = (valid && !forced) ? v + 1u : 0u;
        const int nforced = (sb >= 2) ? 3 : sb + 1; const int R = 16 - nforced;
        bool pick = key > 0u;
        if (__popcll(__ballot(key > 0u)) > R) {
            unsigned T = 0u;
#pragma unroll 1
            for (int bit = 27; bit >= 0; --bit) { const unsigned cand = T | (1u << bit); if (__popcll(__ballot(key >= cand)) >= R) T = cand; }
            const int G = __popcll(__ballot(key > T)); const unsigned long long E = __ballot(key == T);
            const int before = __popcll(E & ((1ull << m) - 1ull));
            pick = (key > T) || (key == T && before < R - G);
        }
        const unsigned long long msk = __ballot(valid && (forced || pick));
        if (c.lane == 0) sel64[qq] = msk; }
    LDS_WAIT();
    __syncthreads();
    reset(st);
    { SlcPol& pol = spol; pol.qpos = qpos; pol.q0w = q0 + sub * 32; pol.hi = c.hi; pol.ssel = sel64[sub * 32 + c.r32]; pol.rt = rt; pol.c31 = TB[(8 + hn) * 1024 + 1023];
      run_branch<true>(c, pol, P + rowbase * N0 + C_KSL + g * 64, P + rowbase * N0 + C_VSL + g * 64, N0, qr, st); }
    WinPol wpol; wpol.t0 = (sb >= 8) ? sb - 8 : 0; wpol.nt = sb - wpol.t0 + 1;
    issue_first(c, wpol, P + rowbase * N0 + C_KWN + g * 64, P + rowbase * N0 + C_VWN + g * 64, N0);
    { float rl[16]; row_to_regs(c, g1 / total_l(st.l), rl);
#pragma unroll
      for (int r = 0; r < 16; ++r) { park[r * 128 + c.lane] += st.o[0][r] * rl[r]; park[r * 128 + 64 + c.lane] += st.o[1][r] * rl[r]; } }
    reset(st);
    { WinPol& pol = wpol; pol.sb = sb; pol.qpos = qpos; pol.hi = c.hi; pol.rt = rt;
      run_branch<true>(c, pol, P + rowbase * N0 + C_KWN + g * 64, P + rowbase * N0 + C_VWN + g * 64, N0, qr, st); }
    { float rl[16]; row_to_regs(c, g2 / total_l(st.l), rl);
#pragma unroll
      for (int r = 0; r < 16; ++r) { st.o[0][r] = st.o[0][r] * rl[r] + park[r * 128 + c.lane]; st.o[1][r] = st.o[1][r] * rl[r] + park[r * 128 + 64 + c.lane]; } }
    LDS_WAIT();
    store_o(c, st.o, O + (rowbase + q0 + sub * 32) * 1024 + (8 + hn) * 64);
    __syncthreads();
}
__device__ __forceinline__ void ph_nsa_flash(Frame& F) {
    if (F.wave >= 4) __builtin_amdgcn_s_setprio(1);
    unsigned* ctr = (unsigned*)(F.ctl + CW_QNSA); LAS int* nxt = (LAS int*)(F.lds + RING_OFF + L_WS + NWAVES * 64 * 4 - 16);
#pragma unroll 1
    for (;;) {
        if (F.tid == 0) *nxt = (int)__hip_atomic_fetch_add(ctr, 1u, __ATOMIC_RELAXED, __HIP_MEMORY_SCOPE_AGENT);
        __syncthreads();
        const int u = __builtin_amdgcn_readfirstlane(*nxt);
        if (u >= 1024) break;
        const int bg = u & 15; nsa_unit(F, bg >> 1, bg & 1, 63 - (u >> 4));
    }
    __builtin_amdgcn_s_setprio(0);
}
}
constexpr int N_PHASES = 16;
__global__ void __launch_bounds__(NWAVES * 64, 2) trunk_fwd(Args args) {
    extern __shared__ __attribute__((aligned(16))) unsigned char lds[];
    Frame F;
    F.lds = (LAS unsigned char*)lds;
    F.MISC = (volatile LAS unsigned*)(F.lds + MISC_OFF);
    F.tid = threadIdx.x; F.lane = F.tid & 63; F.wave = __builtin_amdgcn_readfirstlane(F.tid >> 6);
    F.G = gridDim.x; { const int bx = blockIdx.x; F.vcu = (F.G % 8 == 0) ? (bx % 8) * (F.G / 8) + bx / 8 : bx; }
    F.gw = F.vcu * NWAVES + F.wave; F.NGW = F.G * NWAVES;
    unsigned char* ws = args.ws; F.ws = ws;
    F.ctl = (gu32*)(ws + WS_CTL);
    for (int u = F.tid; u < (LDS_BYTES - LDSCTL_OFF) / 4; u += NWAVES * 64) ((LAS unsigned*)(F.lds + LDSCTL_OFF))[u] = 0u;
    __syncthreads();
    XcdBarrier bar = xcd_barrier_post((unsigned*)(F.ctl + CW_BAR), F.MISC + 8);
    const int lo = args.ph_lo, hi = args.ph_hi;
#define IN(k) (lo <= (k) && (k) < hi)
#define SEAM(k) do { if (IN(k) && IN((k) + 1)) xcd_barrier(bar); { int t_ = threadIdx.x; asm volatile("" : "+v"(t_)); F.tid = t_; F.lane = t_ & 63; } } while (0)
    float* SSQ = (float*)(ws + WS_SSQ);
    LAS float* RSTAB = (LAS float*)(F.lds + LDSCTL_OFF + 1024);
    bf16* XB = (bf16*)(ws + WS_XB); bf16* XL = (bf16*)(ws + WS_XL); bf16* P = (bf16*)(ws + WS_P); bf16* O = (bf16*)(ws + WS_O); bf16* A = (bf16*)(ws + WS_A);

    if (IN(0)) { p0_prologue(F, args); }
    SEAM(0);
    if (IN(1)) {
        pg8::Gemm g{XB, (const bf16*)(ws + WS_WIN0), M, N0G, 1024, 1024}; pg8::StaticOrder S; S.init(M, N0G, F.G, (int)blockIdx.x);
        pg8::EpiProj E{P, N0, SSQ, C2, (1u << 0) | (1u << 1) | (1u << 6) | (1u << 7), 8, (bf16*)(ws + WS_CMPIN), 11, (float*)(ws + WS_GZ), (float*)(ws + WS_KMEAN)};
        pg8::gemm_phase<pg8::EpiProj, pg8::StaticOrder, true, true>(F.lds + RING_OFF, g, S, E, SSQ, RSTAB);
    }
    SEAM(1);
    if (IN(2)) {
        if (F.vcu < 32) {
            pg8::Gemm g{(const bf16*)(ws + WS_CMPIN), (const bf16*)(ws + WS_WCMP), 8192, 512, 2048, 1024}; pg8::CmpOrder S{F.G, F.vcu};
            pg8::EpiSilu E{(bf16*)(ws + WS_HID), (const float*)(ws + WS_POSB)};
            pg8::gemm_phase<pg8::EpiSilu, pg8::CmpOrder, false, true>(F.lds + RING_OFF, g, S, E);
            fa::cmp2_tile(F, F.vcu);
            asm volatile("s_waitcnt vmcnt(0)" ::: "memory"); __syncthreads();
            if (F.tid == 0) { __builtin_amdgcn_fence(__ATOMIC_RELEASE, "agent"); asm volatile("s_waitcnt vmcnt(0)" ::: "memory");
                __hip_atomic_fetch_add((unsigned*)(F.ctl + CW_CMPDONE), 1u, __ATOMIC_RELAXED, __HIP_MEMORY_SCOPE_AGENT); }
            __syncthreads();
        }
        fa::ph_moba_flash(F);
    }
    if (IN(5)) {
        if (F.tid == 0) { unsigned sp = 0; const int want = (F.G >= 32) ? 32 : F.G;
            while ((int)__hip_atomic_load((unsigned*)(F.ctl + CW_CMPDONE), __ATOMIC_RELAXED, __HIP_MEMORY_SCOPE_AGENT) < want) { __builtin_amdgcn_s_sleep(2); if (++sp > (1u << 22)) break; }
            __builtin_amdgcn_fence(__ATOMIC_ACQUIRE, "agent"); asm volatile("s_waitcnt vmcnt(0)" ::: "memory"); }
        __syncthreads();
        fa::ph_nsa_flash(F);
    }
    SEAM(5);
    if (IN(6)) {
        pg8::Gemm g{O, (const bf16*)(ws + WS_WOUT0), M, 1024, 1024, 1024}; pg8::StaticOrder S; S.init(M, 1024, F.G, (int)blockIdx.x);
        pg8::EpiRes0 E{KIN(I_X), nullptr, XB, XL, SSQ + M};
        pg8::gemm_phase<pg8::EpiRes0, pg8::StaticOrder, true, true>(F.lds + RING_OFF, g, S, E);
    }
    SEAM(6);
    if (IN(7)) {
        pg8::Gemm g{XB, (const bf16*)(ws + WS_W1_0), M, FF, 1024, 1024}; pg8::StaticOrder S; S.init(M, FF, F.G, (int)blockIdx.x);
        pg8::EpiUp E{A, FF, SSQ + M};
        pg8::gemm_phase<pg8::EpiUp, pg8::StaticOrder, true, true>(F.lds + RING_OFF, g, S, E, SSQ + M, RSTAB);
    }
    SEAM(7);
    if (IN(8)) {
        pg8::Gemm g{A, (const bf16*)(ws + WS_W2_0), M, 1024, FF, FF}; pg8::StaticOrder S; S.init(M, 1024, F.G, (int)blockIdx.x);
        pg8::EpiRes1 E{nullptr, nullptr, XB, XL, SSQ + 2 * M};
        pg8::gemm_phase<pg8::EpiRes1, pg8::StaticOrder, true, true>(F.lds + RING_OFF, g, S, E);
    }
    SEAM(8);
    if (IN(9)) {
        pg8::Gemm g{XB, (const bf16*)(ws + WS_WIN1), M, N1, 1024, 1024}; pg8::StaticOrder S; S.init(M, N1, F.G, (int)blockIdx.x);
        pg8::EpiProj E{P, N1, SSQ + 2 * M, C2, 0xFu, 1000, (bf16*)(ws + WS_CMPIN), 1000, (float*)(ws + WS_GZ), nullptr};
        pg8::gemm_phase<pg8::EpiProj, pg8::StaticOrder, true, true>(F.lds + RING_OFF, g, S, E, SSQ + 2 * M, RSTAB);
        skinny_gemm(F, XB, (const bf16*)(ws + WS_WF1), SSQ + 2 * M, (float*)(ws + WS_GZ));
    }
    SEAM(9);
    if (IN(10)) { ph_fox_cum(F, args); fa::ph_fox_knorm(F); }
    SEAM(10);
    if (IN(11)) { fa::ph_fox_flash(F); }
    SEAM(11);
    if (IN(12)) {
        pg8::Gemm g{O, (const bf16*)(ws + WS_WOUT1), M, 1024, 1024, 1024}; pg8::StaticOrder S; S.init(M, 1024, F.G, (int)blockIdx.x);
        pg8::EpiRes1 E{nullptr, nullptr, XB, XL, SSQ + 3 * M};
        pg8::gemm_phase<pg8::EpiRes1, pg8::StaticOrder, true, true>(F.lds + RING_OFF, g, S, E);
    }
    SEAM(12);
    if (IN(13)) {
        pg8::Gemm g{XB, (const bf16*)(ws + WS_W1_1), M, FF, 1024, 1024}; pg8::StaticOrder S; S.init(M, FF, F.G, (int)blockIdx.x);
        pg8::EpiUp E{A, FF, SSQ + 3 * M};
        pg8::gemm_phase<pg8::EpiUp, pg8::StaticOrder, true, true>(F.lds + RING_OFF, g, S, E, SSQ + 3 * M, RSTAB);
    }
    SEAM(13);
    if (IN(14)) {
        pg8::Gemm g{A, (const bf16*)(ws + WS_W2_1), M, 1024, FF, FF}; pg8::StaticOrder S; S.init(M, 1024, F.G, (int)blockIdx.x);
        pg8::EpiRes2 E{nullptr, KOUT(), XB, XL, SSQ};
        pg8::gemm_phase<pg8::EpiRes2, pg8::StaticOrder, true, true>(F.lds + RING_OFF, g, S, E);
    }
    SEAM(14);
    if (IN(15)) { ph_final_norm(F, args); }
#undef IN
#undef SEAM
}

extern "C" void kernel_launch(void* const* d_in, const int* in_sizes, int n_in, void* d_out, int out_size, void* d_ws, size_t ws_size, hipStream_t stream) {
    static int grid = 0;
    if (grid == 0) {
        if (n_in != 18 || out_size != M * DM || ws_size < WS_END) { fprintf(stderr, "kernel_launch: unexpected shapes: n_in %d out %d ws %zu (need %zu)\n", n_in, out_size, ws_size, (size_t)WS_END); grid = -1; return; }
        int dev = 0, cus = 0, per_cu = 0;
        if (hipGetDevice(&dev) != hipSuccess || hipDeviceGetAttribute(&cus, hipDeviceAttributeMultiprocessorCount, dev) != hipSuccess) { grid = -1; return; }
        if (hipFuncSetAttribute((const void*)trunk_fwd, hipFuncAttributeMaxDynamicSharedMemorySize, LDS_BYTES) != hipSuccess) { fprintf(stderr, "kernel_launch: hipFuncSetAttribute failed\n"); grid = -1; return; }
        if (hipOccupancyMaxActiveBlocksPerMultiprocessor(&per_cu, (const void*)trunk_fwd, NWAVES * 64, LDS_BYTES) != hipSuccess || per_cu < 1) { fprintf(stderr, "kernel_launch: occupancy query says %d\n", per_cu); per_cu = 1; }
        (void)hipGetLastError();
        grid = cus;
    }
    if (grid < 0) return;
    (void)hipMemsetAsync((char*)d_ws + WS_CTL, 0, CTL_ZERO_BYTES, stream);
    Args a{};
    for (int i = 0; i < 18; ++i) a.in[i] = (const float*)d_in[i];
    a.out = (float*)d_out; a.ws = (unsigned char*)d_ws; a.ph_lo = 0; a.ph_hi = N_PHASES;
    hipLaunchKernelGGL(trunk_fwd, dim3(grid), dim3(NWAVES * 64), LDS_BYTES, stream, a);
}
```
